# Optimizing an MI355X kernel written in HIP

```python
import math
import jax, jax.numpy as jnp
from jax import lax
import numpy as np

D_MODEL = 1024
BATCH = 8
SEQ = 4096
DEPTH = 2

CHUNK = 64
D_FF = 2816
FFN_RES = 0.5
D_CONV = D_MODEL // 2
CONV_A_WIDTH = 31
N_HEADS_B = 8
HEAD_DIM = 64
D_ATTN = N_HEADS_B * HEAD_DIM
Q_BLOCK = 128
CONV_C_WIDTH = 3
D_SHORT = D_MODEL
N_EVEN = (DEPTH + 1) // 2
N_ODD = DEPTH // 2
D_IN_EVEN = 2 * D_CONV + 3 * D_ATTN + N_HEADS_B
D_IN_ODD = 3 * D_SHORT
EPS = 1e-6

kernel_name = "hybrid_conformer_fox_shortconv_trunk"


def rmsnorm(x, g):
    xf = x.astype(jnp.float32)
    y = xf * lax.rsqrt(jnp.mean(xf * xf, axis=-1, keepdims=True) + EPS)
    return (y * g.astype(jnp.float32)).astype(x.dtype)


def swiglu(x, w_gate, w_up, w_down):
    return (jax.nn.silu(x @ w_gate) * (x @ w_up)) @ w_down


def causal_depthwise_conv(x, w):
    k_width = w.shape[0]
    return lax.conv_general_dilated(
        x, w[:, None, :].astype(x.dtype), window_strides=(1,),
        padding=[(k_width - 1, 0)],
        dimension_numbers=("NWC", "WIO", "NWC"),
        feature_group_count=x.shape[-1])


def forgetting_attention(q, k, v, log_f):
    b, s_len, h, dh = q.shape
    nb = s_len // Q_BLOCK
    scale = 1.0 / math.sqrt(dh)
    cum = jnp.cumsum(log_f, axis=1).transpose(0, 2, 1)
    qh = q.transpose(0, 2, 1, 3)
    kh = k.transpose(0, 2, 1, 3)
    vh = v.transpose(0, 2, 1, 3)
    q_blocks = qh.reshape(b, h, nb, Q_BLOCK, dh).transpose(2, 0, 1, 3, 4)
    f_blocks = cum.reshape(b, h, nb, Q_BLOCK).transpose(2, 0, 1, 3)
    q_pos = jnp.arange(s_len).reshape(nb, Q_BLOCK)
    k_pos = jnp.arange(s_len)

    def block(args):
        qi, fi, pi = args
        logits = jnp.einsum("bhqd,bhkd->bhqk", qi, kh,
                            preferred_element_type=jnp.float32) * scale
        logits = logits + fi[..., None] - cum[:, :, None, :]
        logits = jnp.where(k_pos[None, :] <= pi[:, None], logits, -jnp.inf)
        p = jax.nn.softmax(logits, axis=-1)
        return jnp.einsum("bhqk,bhkd->bhqd", p.astype(vh.dtype), vh)

    o = lax.map(block, (q_blocks, f_blocks, q_pos))
    return o.transpose(1, 0, 3, 2, 4).reshape(b, s_len, h * dh)


def even_mixer(h, w_in, b_f, conv_w, conv_b, conv_norm, q_norm, k_norm, w_out):
    b, s_len, _ = h.shape
    z = h @ w_in
    splits = np.cumsum([D_CONV, D_CONV, D_ATTN, D_ATTN, D_ATTN]).tolist()
    u, g, q, k, v, f_logit = jnp.split(z, splits, axis=-1)
    a = u * jax.nn.sigmoid(g)
    a = causal_depthwise_conv(a, conv_w) + conv_b
    a = jax.nn.silu(rmsnorm(a, conv_norm))
    q = rmsnorm(q.reshape(b, s_len, N_HEADS_B, HEAD_DIM), q_norm)
    k = rmsnorm(k.reshape(b, s_len, N_HEADS_B, HEAD_DIM), k_norm)
    v = v.reshape(b, s_len, N_HEADS_B, HEAD_DIM)
    log_f = jax.nn.log_sigmoid(f_logit.astype(jnp.float32) + b_f.astype(jnp.float32))
    o = forgetting_attention(q, k, v, log_f)
    return jnp.concatenate([a, o.astype(a.dtype)], axis=-1) @ w_out


def odd_mixer(h, w_in, conv_w, w_out):
    z = h @ w_in
    gate_b, gate_c, hh = jnp.split(z, 3, axis=-1)
    y = gate_b * causal_depthwise_conv(gate_c * hh, conv_w)
    return y @ w_out


def setup_inputs(seed: int = 0) -> dict:
    key = jax.random.key(seed)
    ks = iter(jax.random.split(key, 32))
    f32 = jnp.float32

    def nrm(shape, fan_in):
        return jax.random.normal(next(ks), shape, f32) * (fan_in ** -0.5)

    def gain(shape):
        return 1.0 + 0.02 * jax.random.normal(next(ks), shape, f32)

    return {
        "x": jax.random.normal(next(ks), (BATCH, SEQ, D_MODEL), f32),
        "ffn1_norm": gain((DEPTH, D_MODEL)),
        "ffn1_w_gate": nrm((DEPTH, D_MODEL, D_FF), D_MODEL),
        "ffn1_w_up": nrm((DEPTH, D_MODEL, D_FF), D_MODEL),
        "ffn1_w_down": nrm((DEPTH, D_FF, D_MODEL), D_FF),
        "mix_norm": gain((DEPTH, D_MODEL)),
        "ffn2_norm": gain((DEPTH, D_MODEL)),
        "ffn2_w_gate": nrm((DEPTH, D_MODEL, D_FF), D_MODEL),
        "ffn2_w_up": nrm((DEPTH, D_MODEL, D_FF), D_MODEL),
        "ffn2_w_down": nrm((DEPTH, D_FF, D_MODEL), D_FF),
        "ev_w_in": nrm((N_EVEN, D_MODEL, D_IN_EVEN), D_MODEL),
        "ev_b_f": jax.random.uniform(next(ks), (N_EVEN, N_HEADS_B), f32, 1.0, 5.0),
        "ev_conv_w": nrm((N_EVEN, CONV_A_WIDTH, D_CONV), CONV_A_WIDTH),
        "ev_conv_b": 0.01 * jax.random.normal(next(ks), (N_EVEN, D_CONV), f32),
        "ev_conv_norm": gain((N_EVEN, D_CONV)),
        "ev_q_norm": gain((N_EVEN, HEAD_DIM)),
        "ev_k_norm": gain((N_EVEN, HEAD_DIM)),
        "ev_w_out": nrm((N_EVEN, D_CONV + D_ATTN, D_MODEL), D_CONV + D_ATTN),
        "od_w_in": nrm((N_ODD, D_MODEL, D_IN_ODD), D_MODEL),
        "od_conv_w": nrm((N_ODD, CONV_C_WIDTH, D_SHORT), CONV_C_WIDTH),
        "od_w_out": nrm((N_ODD, D_SHORT, D_MODEL), D_SHORT),
    }


def reference(x, ffn1_norm, ffn1_w_gate, ffn1_w_up, ffn1_w_down, mix_norm,
              ffn2_norm, ffn2_w_gate, ffn2_w_up, ffn2_w_down,
              ev_w_in, ev_b_f, ev_conv_w, ev_conv_b, ev_conv_norm, ev_q_norm,
              ev_k_norm, ev_w_out, od_w_in, od_conv_w, od_w_out):
    for layer in range(DEPTH):
        x = x + FFN_RES * swiglu(rmsnorm(x, ffn1_norm[layer]), ffn1_w_gate[layer],
                                 ffn1_w_up[layer], ffn1_w_down[layer])
        h = rmsnorm(x, mix_norm[layer])
        if layer % 2 == 0:
            i = layer // 2
            x = x + even_mixer(h, ev_w_in[i], ev_b_f[i], ev_conv_w[i], ev_conv_b[i],
                               ev_conv_norm[i], ev_q_norm[i], ev_k_norm[i], ev_w_out[i])
        else:
            i = layer // 2
            x = x + odd_mixer(h, od_w_in[i], od_conv_w[i], od_w_out[i])
        x = x + FFN_RES * swiglu(rmsnorm(x, ffn2_norm[layer]), ffn2_w_gate[layer],
                                 ffn2_w_up[layer], ffn2_w_down[layer])
    return x
```

```cpp
#include <hip/hip_runtime.h>
#include <hip/hip_cooperative_groups.h>
#include <cstdio>
#include <cstdint>
#include <cmath>
namespace cg = cooperative_groups;
#define PG8_WGM 4
namespace pg8 {
#define PG8_LAS __attribute__((address_space(3)))
typedef unsigned short bf16_t;
typedef short bf16x8 __attribute__((ext_vector_type(8)));
typedef float f32x4 __attribute__((ext_vector_type(4)));
typedef unsigned u32x4 __attribute__((ext_vector_type(4)));
constexpr int BM = 256, BK = 64, HALF = 128, HTB = HALF * BK * 2  , STAGE_BYTES = 8 * HTB, NXCD = 8;
#ifndef PG8_WGM
#define PG8_WGM 8
#endif
constexpr int WGM = PG8_WGM;

__host__ __device__ __forceinline__ int lds_byte(int r, int c) { const int st = (r >> 4) * 2 + (c >> 5), rr = r & 15, cc = c & 31, ob = rr * 64 + cc * 2; return st * 1024 + (ob ^ (((ob >> 9) & 1) << 5)); }
__host__ __device__ __forceinline__ void stage_rc(int b, int& R, int& C) { const int st = b / 1024, sb = b % 1024, swz = sb ^ (((sb >> 9) & 1) << 5); R = (st >> 1) * 16 + swz / 64; C = (st & 1) * 32 + (swz % 64) / 2; }
__host__ __device__ __forceinline__ int perm32(int rho) { const int n = rho >> 4, i = rho & 15; return 8 * (i >> 2) + 4 * n + (i & 3); }

struct Unit { int pm, pn; };
struct Gemm { const bf16_t* A; const bf16_t* Bt; int M, N, K; };

struct StaticOrder {
    int nM, nN, nwg, G, c;
    __host__ __device__ void init(int M, int N, int G_, int c_) { nM = M / BM; nN = N / BM; nwg = nM * nN; G = G_; c = c_; }
    __host__ __device__ bool next(int i, Unit& u) const {
        const long L = (long)i * G + c; if (L >= nwg) return false;
        int wgid = (int)L; { const int q = nwg / NXCD, r = nwg % NXCD, xcd = wgid % NXCD, off = wgid / NXCD; wgid = (xcd < r ? xcd * (q + 1) : r * (q + 1) + (xcd - r) * q) + off; }
        const int nig = WGM * nN, gid = wgid / nig, fm = gid * WGM, gsz = (nM - fm) < WGM ? (nM - fm) : WGM;
        u.pm = fm + ((wgid % nig) % gsz); u.pn = (wgid % nig) / gsz; return true;
    }
    __device__ __forceinline__ void a_ready(const Unit&) const {}
    __device__ __forceinline__ void done(const Unit&) const {}
};

__device__ __forceinline__ unsigned cvt_pk_bf16(float lo, float hi) { unsigned r; asm volatile("v_cvt_pk_bf16_f32 %0, %1, %2" : "=v"(r) : "v"(lo), "v"(hi)); return r; }
typedef float f32x2 __attribute__((ext_vector_type(2)));
constexpr float RMS_EPS = 1e-6f;
constexpr float LOG2E = 1.4426950408889634f;
__device__ __forceinline__ float rstd_row(const float* ssp, int row, int fq) {
    const f32x4 v = *(const f32x4*)(ssp + (size_t)row * 16 + fq * 4);
    float s = (v[0] + v[1]) + (v[2] + v[3]);
    s += __shfl_xor(s, 16); s += __shfl_xor(s, 32);
    return __builtin_amdgcn_rsqf(s * (1.0f / 1024.0f) + RMS_EPS);
}
constexpr int RTAB_OFF = STAGE_BYTES + 1024, RT_MAX = 14;
template <class Sched> __device__ __forceinline__ void rtab_fill(PG8_LAS unsigned char* lds, const float* ssp, const Sched& S) {
    PG8_LAS float* rtab = (PG8_LAS float*)(lds + RTAB_OFF); Unit u; const int tid = threadIdx.x;
    for (int i = 0; i < RT_MAX && S.next(i, u); ++i) { const int r = tid >> 1, hf = tid & 1;
        const f32x4* p = (const f32x4*)(ssp + (size_t)(u.pm * BM + r) * 16 + hf * 8); const f32x4 a = p[0], b = p[1];
        float s = ((a[0] + a[1]) + (a[2] + a[3])) + ((b[0] + b[1]) + (b[2] + b[3])); s += __shfl_xor(s, 1);
        if (hf == 0) rtab[i * BM + r] = __builtin_amdgcn_rsqf(s * (1.0f / 1024.0f) + RMS_EPS); }
}
__device__ __forceinline__ void rstd_rows(const float* ssp, int row0, int fq, float (&rs)[2][4], int ui, int lrow0, PG8_LAS unsigned char* lds) {
    if (ui < RT_MAX) { const PG8_LAS float* rtab = (const PG8_LAS float*)(lds + RTAB_OFF) + ui * BM + lrow0;
#pragma unroll
        for (int ai = 0; ai < 2; ++ai)
#pragma unroll
            for (int m = 0; m < 4; ++m) rs[ai][m] = rtab[ai * HALF + m * 16];
        return; }
    f32x4 v[2][4];
#pragma unroll
    for (int ai = 0; ai < 2; ++ai)
#pragma unroll
        for (int m = 0; m < 4; ++m) v[ai][m] = *(const f32x4*)(ssp + (size_t)(row0 + ai * HALF + m * 16) * 16 + fq * 4);
#pragma unroll
    for (int ai = 0; ai < 2; ++ai)
#pragma unroll
        for (int m = 0; m < 4; ++m) { float s = (v[ai][m][0] + v[ai][m][1]) + (v[ai][m][2] + v[ai][m][3]); s += __shfl_xor(s, 16); s += __shfl_xor(s, 32); rs[ai][m] = __builtin_amdgcn_rsqf(s * (1.0f / 1024.0f) + RMS_EPS); }
}
__device__ __forceinline__ float sigmoid_f(float x) { return __builtin_amdgcn_rcpf(1.0f + __builtin_amdgcn_exp2f(-x * LOG2E)); }
__device__ __forceinline__ float silu_f(float x) { return x * sigmoid_f(x); }
__device__ __forceinline__ u32x4 pack8(const f32x4 a, const f32x4 b) { u32x4 w; w.x = cvt_pk_bf16(a[0], a[1]); w.y = cvt_pk_bf16(a[2], a[3]); w.z = cvt_pk_bf16(b[0], b[1]); w.w = cvt_pk_bf16(b[2], b[3]); return w; }

struct EpiSwiglu {
    static constexpr bool PERM = true, AFTER_DRAIN = false;
    bf16_t* H; const float* ssp; int ldh;
    template <class Sched> __device__ __forceinline__ void phase_prologue(PG8_LAS unsigned char* lds, const Sched& S) const { rtab_fill(lds, ssp, S); }
    __device__ __forceinline__ void operator()(const f32x4 (&acc)[2][2][4][2], const Unit& u, int wr, int wc, int fr, int fq, int ui, PG8_LAS unsigned char* lds) const {
        const int row0 = u.pm * BM + wr * 64 + fr, col0 = u.pn * HALF + wc * 32 + 8 * fq;
        float rsv[2][4]; rstd_rows(ssp, row0, fq, rsv, ui, wr * 64 + fr, lds);
#pragma unroll
        for (int ai = 0; ai < 2; ++ai)
#pragma unroll
            for (int m = 0; m < 4; ++m) {
                const int row = row0 + ai * HALF + m * 16; const float rs = rsv[ai][m];
                f32x4 h[2]; const float nrs = -rs * LOG2E, irr = __builtin_amdgcn_rcpf(rs * rs);
                const f32x4 irr4 = (f32x4){irr, irr, irr, irr};
#pragma unroll
                for (int n = 0; n < 2; ++n) { const f32x4 g = acc[ai][0][m][n], up = acc[ai][1][m][n]; const f32x4 t = g * nrs; f32x4 e;
#pragma unroll
                    for (int j = 0; j < 4; ++j) e[j] = __builtin_amdgcn_exp2f(t[j]);
                    const f32x4 d = __builtin_elementwise_fma(e, irr4, irr4); f32x4 r;
#pragma unroll
                    for (int j = 0; j < 4; ++j) r[j] = __builtin_amdgcn_rcpf(d[j]);
                    h[n] = (g * up) * r; }
                *(u32x4*)(H + (size_t)row * ldh + col0) = pack8(h[0], h[1]);
            }
    }
};
template <bool FINAL> struct EpiResid {
    static constexpr bool PERM = true, AFTER_DRAIN = false;
    float* xout; bf16_t* xb; float* ssp; float alpha;
    template <class Sched> __device__ __forceinline__ void phase_prologue(PG8_LAS unsigned char*, const Sched&) const {}
    __device__ __forceinline__ void operator()(const f32x4 (&acc)[2][2][4][2], const Unit& u, int wr, int wc, int fr, int fq, int ui, PG8_LAS unsigned char* lds) const {
        const int row0 = u.pm * BM + wr * 64 + fr, col0 = u.pn * BM + wc * 32 + 8 * fq;
        u32x4 xv[8][2];
#pragma unroll
        for (int it = 0; it < 8; ++it) { const size_t off = (size_t)(row0 + (it >> 2) * HALF + (it & 3) * 16) * 1024 + col0; xv[it][0] = *(const u32x4*)(xb + off); xv[it][1] = *(const u32x4*)(xb + off + HALF); }
#pragma unroll
        for (int it = 0; it < 8; ++it) {
            const int ai = it >> 2, m = it & 3;
            const int row = row0 + ai * HALF + m * 16; const size_t off = (size_t)row * 1024 + col0; f32x4 sq = (f32x4){0.f, 0.f, 0.f, 0.f};
#pragma unroll
            for (int bj = 0; bj < 2; ++bj) {
                const u32x4 xw = xv[it][bj];
                const f32x4 a0 = (f32x4){__uint_as_float(xw.x << 16), __uint_as_float(xw.x & 0xffff0000u), __uint_as_float(xw.y << 16), __uint_as_float(xw.y & 0xffff0000u)};
                const f32x4 a1 = (f32x4){__uint_as_float(xw.z << 16), __uint_as_float(xw.z & 0xffff0000u), __uint_as_float(xw.w << 16), __uint_as_float(xw.w & 0xffff0000u)};
                const f32x4 v0 = a0 + acc[ai][bj][m][0] * alpha, v1 = a1 + acc[ai][bj][m][1] * alpha;
                if constexpr (FINAL) { __builtin_nontemporal_store(v0, (f32x4*)(xout + off + bj * HALF)); __builtin_nontemporal_store(v1, (f32x4*)(xout + off + bj * HALF + 4)); }
                else {
                    *(u32x4*)(xb + off + bj * HALF) = pack8(v0, v1);
                    sq = __builtin_elementwise_fma(v0, v0, sq); sq = __builtin_elementwise_fma(v1, v1, sq); }
            }
            if constexpr (!FINAL) { float s = (sq[0] + sq[1]) + (sq[2] + sq[3]); s += __shfl_xor(s, 16); s += __shfl_xor(s, 32); if (fq == 0) ssp[(size_t)row * 16 + u.pn * 4 + wc] = s; }
        }
    }
};
struct EpiEvenIn {
    static constexpr bool PERM = true, AFTER_DRAIN = false;
    bf16_t* QK; bf16_t* VA; float* LF; const float* ssp; const float* qg; const float* kg; const float* bfp;
    template <class Sched> __device__ __forceinline__ void phase_prologue(PG8_LAS unsigned char* lds, const Sched& S) const { rtab_fill(lds, ssp, S); }
    __device__ __forceinline__ void operator()(const f32x4 (&acc)[2][2][4][2], const Unit& u, int wr, int wc, int fr, int fq, int ui, PG8_LAS unsigned char* lds) const {
        const int row0 = u.pm * BM + wr * 64 + fr; const int pn = u.pn;
        float rsv[2][4]; rstd_rows(ssp, row0, fq, rsv, ui, wr * 64 + fr, lds);
        if (pn < 4) {
            const int col0 = 512 + pn * HALF + wc * 32 + 8 * fq;
#pragma unroll
            for (int ai = 0; ai < 2; ++ai)
#pragma unroll
                for (int m = 0; m < 4; ++m) { const int row = row0 + ai * HALF + m * 16; const float rs = rsv[ai][m]; f32x4 h[2];
#pragma unroll
                    for (int n = 0; n < 2; ++n) { const f32x4 uu = acc[ai][0][m][n] * rs, g = acc[ai][1][m][n] * rs;
#pragma unroll
                        for (int j = 0; j < 4; ++j) h[n][j] = uu[j] * sigmoid_f(g[j]); }
                    *(u32x4*)(VA + (size_t)row * 1024 + col0) = pack8(h[0], h[1]); }
        } else if (pn < 8) {
            const bool isk = pn >= 6; const int head = 4 * (pn & 1) + wc; const float* gp = isk ? kg : qg; const float post = isk ? 1.0f : 0.125f * LOG2E;
            f32x4 gn[2][2];
#pragma unroll
            for (int bj = 0; bj < 2; ++bj)
#pragma unroll
                for (int n = 0; n < 2; ++n) gn[bj][n] = *(const f32x4*)(gp + 32 * bj + 8 * fq + 4 * n) * post;
            const int col0 = (isk ? 512 : 0) + head * 64 + 8 * fq;
#pragma unroll
            for (int ai = 0; ai < 2; ++ai)
#pragma unroll
                for (int m = 0; m < 4; ++m) { const int row = row0 + ai * HALF + m * 16; const float rs = rsv[ai][m]; f32x4 v[2][2]; float s = 0.f;
#pragma unroll
                    for (int bj = 0; bj < 2; ++bj)
#pragma unroll
                        for (int n = 0; n < 2; ++n) { v[bj][n] = acc[ai][bj][m][n] * rs; s += (v[bj][n][0] * v[bj][n][0] + v[bj][n][1] * v[bj][n][1]) + (v[bj][n][2] * v[bj][n][2] + v[bj][n][3] * v[bj][n][3]); }
                    s += __shfl_xor(s, 16); s += __shfl_xor(s, 32);
                    const float hr = __builtin_amdgcn_rsqf(s * (1.0f / 64.0f) + RMS_EPS);
#pragma unroll
                    for (int bj = 0; bj < 2; ++bj) *(u32x4*)(QK + (size_t)row * 1024 + col0 + 32 * bj) = pack8(v[bj][0] * hr * gn[bj][0], v[bj][1] * hr * gn[bj][1]); }
        } else if (pn < 10) {
            const int col0 = (pn - 8) * BM + wc * 32 + 8 * fq;
#pragma unroll
            for (int ai = 0; ai < 2; ++ai)
#pragma unroll
                for (int m = 0; m < 4; ++m) { const int row = row0 + ai * HALF + m * 16; const float rs = rsv[ai][m];
#pragma unroll
                    for (int bj = 0; bj < 2; ++bj) *(u32x4*)(VA + (size_t)row * 1024 + col0 + bj * HALF) = pack8(acc[ai][bj][m][0] * rs, acc[ai][bj][m][1] * rs); }
        } else {
#pragma unroll
            for (int ai = 0; ai < 2; ++ai)
#pragma unroll
                for (int m = 0; m < 4; ++m) { const int row = row0 + ai * HALF + m * 16; const float rs = rsv[ai][m];
                    if (wc == 0 && fq == 0) { const int b = row >> 12, t = row & 4095;
#pragma unroll
                        for (int n = 0; n < 2; ++n)
#pragma unroll
                            for (int j = 0; j < 4; ++j) { const int h = 4 * n + j; const float z = acc[ai][0][m][n][j] * rs + bfp[h];
                                LF[(size_t)(b * 8 + h) * 4096 + t] = fminf(z, 0.f) - log1pf(__expf(-fabsf(z))); } } }
        }
    }
};
struct EpiOddIn {
    static constexpr bool PERM = true, AFTER_DRAIN = false;
    bf16_t* CC; bf16_t* GB; const float* ssp;
    template <class Sched> __device__ __forceinline__ void phase_prologue(PG8_LAS unsigned char* lds, const Sched& S) const { rtab_fill(lds, ssp, S); }
    __device__ __forceinline__ void operator()(const f32x4 (&acc)[2][2][4][2], const Unit& u, int wr, int wc, int fr, int fq, int ui, PG8_LAS unsigned char* lds) const {
        const int row0 = u.pm * BM + wr * 64 + fr; const int pn = u.pn;
        float rsv[2][4]; rstd_rows(ssp, row0, fq, rsv, ui, wr * 64 + fr, lds);
        if (pn < 8) {
            const int col0 = pn * HALF + wc * 32 + 8 * fq;
#pragma unroll
            for (int ai = 0; ai < 2; ++ai)
#pragma unroll
                for (int m = 0; m < 4; ++m) { const int row = row0 + ai * HALF + m * 16; const float rs = rsv[ai][m]; const float rs2 = rs * rs;
                    *(u32x4*)(CC + (size_t)row * 1024 + col0) = pack8(acc[ai][0][m][0] * acc[ai][1][m][0] * rs2, acc[ai][0][m][1] * acc[ai][1][m][1] * rs2); }
        } else {
            const int col0 = (pn - 8) * BM + wc * 32 + 8 * fq;
#pragma unroll
            for (int ai = 0; ai < 2; ++ai)
#pragma unroll
                for (int m = 0; m < 4; ++m) { const int row = row0 + ai * HALF + m * 16; const float rs = rsv[ai][m];
#pragma unroll
                    for (int bj = 0; bj < 2; ++bj) *(u32x4*)(GB + (size_t)row * 1024 + col0 + bj * HALF) = pack8(acc[ai][bj][m][0] * rs, acc[ai][bj][m][1] * rs); }
        }
    }
};
template <class Epi, class Sched, bool ALIGN_EPI = false, bool SP2 = false>
__device__ __forceinline__ void gemm_phase(PG8_LAS unsigned char* lds, const Gemm g, const Sched& S, const Epi& E) {
    const int tid = threadIdx.x, wid = __builtin_amdgcn_readfirstlane(tid >> 6), lane = tid & 63, wr = wid >> 2, wc = wid & 3, fr = lane & 15, fq = lane >> 4;
    const int K = g.K, nt = K / BK;
    unsigned voffA[2], voffB[2];
#pragma unroll
    for (int i = 0; i < 2; ++i) { int R, C; stage_rc(tid * 16 + i * 8192, R, C); const int Rb = Epi::PERM ? ((R & ~31) + perm32(R & 31)) : R;
        voffA[i] = (unsigned)(R * K + C) * 2u; voffB[i] = (unsigned)(Rb * K + C) * 2u; }
    const size_t kstep = (size_t)(BK * 2);
    const size_t hstep = (size_t)HALF * K * 2;
    const size_t tstep = 2 * hstep;
    const unsigned ldsw = (unsigned)wid * 1024u;
    const int aoff = lds_byte(wr * 64 + fr, fq * 8), boff = lds_byte(wc * 32 + fr, fq * 8);
#define PG8_SA(b, h) (((b) * 2 + (h)) * HTB)
#define PG8_SB(b, h) ((4 + (b) * 2 + (h)) * HTB)
#define PG8_STAGE(bufoff, gbase, voff) do { _Pragma("unroll") for (int _i = 0; _i < 2; ++_i) \
        __builtin_amdgcn_global_load_lds((const unsigned*)((const char*)(gbase) + (voff)[_i]), (PG8_LAS unsigned*)(lds + (bufoff) + ldsw + _i * 8192), 16, 0, 0); } while (0)
#define PG8_LDA(dst, b, h) do { _Pragma("unroll") for (int m = 0; m < 4; ++m) _Pragma("unroll") for (int k = 0; k < 2; ++k) dst[m][k] = *(const PG8_LAS bf16x8*)(lds + PG8_SA(b, h) + aoff + m * 2048 + k * 1024); } while (0)
#define PG8_LDB(dst, b, h) do { _Pragma("unroll") for (int n = 0; n < 2; ++n) _Pragma("unroll") for (int k = 0; k < 2; ++k) dst[n][k] = *(const PG8_LAS bf16x8*)(lds + PG8_SB(b, h) + boff + n * 2048 + k * 1024); } while (0)
#define PG8_MMA(ai, bj, At, Bt) do { __builtin_amdgcn_s_setprio(1); _Pragma("unroll") for (int m = 0; m < 4; ++m) _Pragma("unroll") for (int n = 0; n < 2; ++n) _Pragma("unroll") for (int k = 0; k < 2; ++k) \
        acc[ai][bj][m][n] = __builtin_amdgcn_mfma_f32_16x16x32_bf16(Bt[n][k], At[m][k], acc[ai][bj][m][n], 0, 0, 0); __builtin_amdgcn_s_setprio(0); } while (0)
#define PG8_WAIT_V(n) asm volatile("s_waitcnt vmcnt(" #n ")" ::: "memory")
#define PG8_WAIT_L(n) asm volatile("s_waitcnt lgkmcnt(" #n ")" ::: "memory")
#define PG8_BAR __builtin_amdgcn_s_barrier()
#define PG8_SCHED __builtin_amdgcn_sched_barrier(0)
    Unit cur, nxt; int ui = 0;
    if (!S.next(0, cur)) return;
    f32x4 acc[2][2][4][2];
#pragma unroll
    for (int a = 0; a < 2; ++a)
#pragma unroll
        for (int b = 0; b < 2; ++b)
#pragma unroll
            for (int m = 0; m < 4; ++m)
#pragma unroll
                for (int n = 0; n < 2; ++n) acc[a][b][m][n] = (f32x4){0.f, 0.f, 0.f, 0.f};
    bf16x8 At[4][2], B0[2][2], B1[2][2];
    const char* cA = (const char*)g.A + (size_t)cur.pm * tstep; const char* cB = (const char*)g.Bt + (size_t)cur.pn * tstep;
    S.a_ready(cur);
    if constexpr (SP2) {
        PG8_STAGE(PG8_SB(0, 0), cB, voffB); PG8_STAGE(PG8_SB(0, 1), cB + hstep, voffB); PG8_STAGE(PG8_SA(0, 0), cA, voffA); PG8_STAGE(PG8_SA(0, 1), cA + hstep, voffA);
        E.phase_prologue(lds, S);
        if (wr == 1) PG8_BAR;
        PG8_WAIT_V(2); PG8_BAR;
        PG8_STAGE(PG8_SB(1, 0), cB + kstep, voffB); PG8_STAGE(PG8_SA(1, 0), cA + kstep, voffA); PG8_STAGE(PG8_SB(1, 1), cB + hstep + kstep, voffB);
        PG8_WAIT_V(6); PG8_BAR;
    } else {
        PG8_STAGE(PG8_SB(0, 0), cB, voffB); PG8_STAGE(PG8_SA(0, 0), cA, voffA); PG8_STAGE(PG8_SB(0, 1), cB + hstep, voffB); PG8_STAGE(PG8_SA(0, 1), cA + hstep, voffA);
        if (wr == 1) PG8_BAR;
        PG8_WAIT_V(4); PG8_BAR;
        PG8_STAGE(PG8_SB(1, 0), cB + kstep, voffB); PG8_STAGE(PG8_SA(1, 0), cA + kstep, voffA); PG8_STAGE(PG8_SB(1, 1), cB + hstep + kstep, voffB);
        PG8_WAIT_V(6); PG8_BAR;
    }
    for (;;) {
        const bool has_next = S.next(ui + 1, nxt);
        const char* nA = has_next ? (const char*)g.A + (size_t)nxt.pm * tstep : cA; const char* nB = has_next ? (const char*)g.Bt + (size_t)nxt.pn * tstep : cB;
        for (int t = 0; t < nt; t += 2) {
            const bool last = (t == nt - 2);
            const char* a1 = cA + (size_t)(t + 1) * kstep;
            const char* a2 = last ? nA : cA + (size_t)(t + 2) * kstep; const char* b2 = last ? nB : cB + (size_t)(t + 2) * kstep;
            const char* a3 = a2 + kstep; const char* b3 = b2 + kstep;
            if (last && has_next) S.a_ready(nxt);
            if constexpr (SP2) {
            PG8_LDB(B0, 0, 0); PG8_LDB(B1, 0, 1); PG8_SCHED; PG8_LDA(At, 0, 0); PG8_STAGE(PG8_SA(1, 1), a1 + hstep, voffA);
            PG8_WAIT_V(8); PG8_WAIT_L(0); PG8_BAR; PG8_MMA(0, 0, At, B0); PG8_MMA(0, 1, At, B1); PG8_BAR; PG8_SCHED;
            PG8_LDA(At, 0, 1); PG8_STAGE(PG8_SB(0, 0), b2, voffB); PG8_STAGE(PG8_SB(0, 1), b2 + hstep, voffB); PG8_STAGE(PG8_SA(0, 0), a2, voffA);
            PG8_WAIT_V(8); PG8_WAIT_L(0); PG8_BAR; PG8_MMA(1, 0, At, B0); PG8_MMA(1, 1, At, B1); PG8_BAR; PG8_SCHED;
            PG8_LDB(B0, 1, 0); PG8_LDB(B1, 1, 1); PG8_SCHED; PG8_LDA(At, 1, 0); PG8_STAGE(PG8_SA(0, 1), a2 + hstep, voffA);
            PG8_WAIT_V(8); PG8_WAIT_L(0); PG8_BAR; PG8_MMA(0, 0, At, B0); PG8_MMA(0, 1, At, B1); PG8_BAR; PG8_SCHED;
            PG8_LDA(At, 1, 1); PG8_STAGE(PG8_SB(1, 0), b3, voffB); PG8_STAGE(PG8_SB(1, 1), b3 + hstep, voffB); PG8_STAGE(PG8_SA(1, 0), a3, voffA);
            PG8_WAIT_V(8); PG8_WAIT_L(0); PG8_BAR; PG8_MMA(1, 0, At, B0); PG8_MMA(1, 1, At, B1); PG8_BAR; PG8_SCHED;
            } else {
            PG8_LDB(B0, 0, 0); PG8_SCHED; PG8_LDA(At, 0, 0); PG8_STAGE(PG8_SA(1, 1), a1 + hstep, voffA);
            PG8_WAIT_L(8); PG8_BAR; PG8_WAIT_L(0); PG8_MMA(0, 0, At, B0); PG8_BAR; PG8_SCHED;
            PG8_LDB(B1, 0, 1); PG8_STAGE(PG8_SB(0, 0), b2, voffB);
            PG8_BAR; PG8_WAIT_L(0); PG8_MMA(0, 1, At, B1); PG8_BAR;
            PG8_LDA(At, 0, 1); PG8_STAGE(PG8_SA(0, 0), a2, voffA);
            PG8_BAR; PG8_WAIT_L(0); PG8_MMA(1, 0, At, B0); PG8_BAR; PG8_SCHED;
            PG8_STAGE(PG8_SB(0, 1), b2 + hstep, voffB);
            PG8_WAIT_V(6); PG8_BAR; PG8_MMA(1, 1, At, B1); PG8_BAR;
            PG8_LDB(B0, 1, 0); PG8_SCHED; PG8_LDA(At, 1, 0); PG8_STAGE(PG8_SA(0, 1), a2 + hstep, voffA);
            PG8_WAIT_L(8); PG8_BAR; PG8_WAIT_L(0); PG8_MMA(0, 0, At, B0); PG8_BAR; PG8_SCHED;
            PG8_LDB(B1, 1, 1); PG8_STAGE(PG8_SB(1, 0), b3, voffB);
            PG8_BAR; PG8_WAIT_L(0); PG8_MMA(0, 1, At, B1); PG8_BAR;
            PG8_LDA(At, 1, 1); PG8_STAGE(PG8_SA(1, 0), a3, voffA);
            PG8_BAR; PG8_WAIT_L(0); PG8_MMA(1, 0, At, B0); PG8_BAR; PG8_SCHED;
            PG8_STAGE(PG8_SB(1, 1), b3 + hstep, voffB);
            PG8_WAIT_V(6); PG8_BAR; PG8_MMA(1, 1, At, B1); PG8_BAR;
            }
        }
        if constexpr (ALIGN_EPI) { if (wr == 0) PG8_BAR; }
        if constexpr (!Epi::AFTER_DRAIN) { E(acc, cur, wr, wc, fr, fq, ui, lds); S.done(cur); }
        if (!has_next) break;
#pragma unroll
        for (int a = 0; a < 2; ++a)
#pragma unroll
            for (int b = 0; b < 2; ++b)
#pragma unroll
                for (int m = 0; m < 4; ++m)
#pragma unroll
                    for (int n = 0; n < 2; ++n) acc[a][b][m][n] = (f32x4){0.f, 0.f, 0.f, 0.f};
        cur = nxt; cA = nA; cB = nB; ++ui;
        if constexpr (ALIGN_EPI) { if (wr == 1) PG8_BAR; }
    }
    PG8_WAIT_V(0);
    if constexpr (!ALIGN_EPI) { if (wr == 0) PG8_BAR; }
    PG8_BAR;
    if constexpr (Epi::AFTER_DRAIN) { E.fused(acc, cur, wr, wc, fr, fq, lds, wid, lane); S.done(cur); }
#undef PG8_SA
#undef PG8_SB
#undef PG8_STAGE
#undef PG8_LDA
#undef PG8_LDB
#undef PG8_MMA
#undef PG8_WAIT_V
#undef PG8_WAIT_L
#undef PG8_BAR
#undef PG8_SCHED
}
}
namespace att {
typedef short bf16x8 __attribute__((ext_vector_type(8)));
typedef short s16x4 __attribute__((ext_vector_type(4)));
typedef float f32x16 __attribute__((ext_vector_type(16)));
typedef float f32x4 __attribute__((ext_vector_type(4)));
typedef unsigned u32x4 __attribute__((ext_vector_type(4)));
typedef unsigned short bf16_t;
constexpr int SEQ = 4096, PITCH = 1024, QB = 256, KVBLK = 64, NW = 8, SLOTB = 8192;
constexpr int NSLOT = 4; constexpr int L_K = 0, L_V = NSLOT * SLOTB, L_BIAS = 2 * NSLOT * SLOTB, L_WS = L_BIAS + SEQ * 4, L_OST = L_WS + NW * 64 * 4, L_BYTES = L_OST + NW * 4096;
__device__ __forceinline__ int crow(int r, int hi) { return (r & 3) + 8 * (r >> 2) + 4 * hi; }
__device__ __forceinline__ void glds16(const void* gsrc, unsigned lds_dst) { unsigned keep;
    asm volatile("s_mov_b32 %0, m0\n\ts_mov_b32 m0, %2\n\ts_nop 0\n\tglobal_load_lds_dwordx4 %1, off\n\ts_mov_b32 m0, %0" : "=&s"(keep) : "v"(gsrc), "s"(lds_dst) : "memory"); }
typedef float f32x2_t __attribute__((ext_vector_type(2))); typedef __bf16 bf16x2_t __attribute__((ext_vector_type(2)));
__device__ __forceinline__ unsigned cvtpk_s(float lo, float hi) { f32x2_t v = {lo, hi}; bf16x2_t b = __builtin_convertvector(v, bf16x2_t); return __builtin_bit_cast(unsigned, b); }
#define ATT_WAIT_BAR() asm volatile("s_waitcnt vmcnt(0) lgkmcnt(0)\n\ts_barrier" ::: "memory")
__device__ __forceinline__ void pv(f32x16* o, int vb, bf16x8 pa0, bf16x8 pa1, bf16x8 pa2, bf16x8 pa3) {
#pragma unroll
    for (int d0 = 0; d0 < 2; ++d0) { s16x4 lo[4], hi[4];
#pragma unroll
        for (int ks = 0; ks < 4; ++ks) {
            asm volatile("ds_read_b64_tr_b16 %0,%1 offset:%c2" : "=&v"(lo[ks]) : "v"(vb), "i"(d0 * 4096 + ks * 1024) : "memory");
            asm volatile("ds_read_b64_tr_b16 %0,%1 offset:%c2" : "=&v"(hi[ks]) : "v"(vb), "i"(d0 * 4096 + ks * 1024 + 512) : "memory"); }
        asm volatile("s_waitcnt lgkmcnt(0)" ::: "memory"); __builtin_amdgcn_sched_barrier(0);
#define ATT_PK(k) (bf16x8){lo[k][0], lo[k][1], lo[k][2], lo[k][3], hi[k][0], hi[k][1], hi[k][2], hi[k][3]}
        o[d0] = __builtin_amdgcn_mfma_f32_32x32x16_bf16(pa0, ATT_PK(0), o[d0], 0, 0, 0);
        o[d0] = __builtin_amdgcn_mfma_f32_32x32x16_bf16(pa1, ATT_PK(1), o[d0], 0, 0, 0);
        o[d0] = __builtin_amdgcn_mfma_f32_32x32x16_bf16(pa2, ATT_PK(2), o[d0], 0, 0, 0);
        o[d0] = __builtin_amdgcn_mfma_f32_32x32x16_bf16(pa3, ATT_PK(3), o[d0], 0, 0, 0);
#undef ATT_PK
    }
}
typedef __attribute__((address_space(3))) const char* lds_cptr;
typedef __attribute__((address_space(3))) float* lds_fptr;
__device__ __forceinline__ void attn_unit(int b, int h, int qb, const bf16_t* QKb, const bf16_t* VAb, bf16_t* CAT, const float* FC, char* shm) {
    const int tid = threadIdx.x, lane = tid & 63, r32 = lane & 31, hi = lane >> 5; const int wid = __builtin_amdgcn_readfirstlane(tid >> 6);
    const long rowbase = (long)b * SEQ; const int q0 = qb * QB;
    const bf16_t* Qw = QKb + (rowbase + q0 + wid * 32) * PITCH + h * 64;
    const bf16_t* Kh = QKb + rowbase * PITCH + 512 + h * 64; const bf16_t* Vh = VAb + rowbase * PITCH + h * 64;
    const unsigned lds0 = (unsigned)(uintptr_t)shm;
    const lds_cptr shm3 = (lds_cptr)shm;
    lds_fptr wsf = (lds_fptr)(shm3 + L_WS) + wid * 64;
    lds_fptr bt = (lds_fptr)(shm3 + L_BIAS);
    const bf16_t* ksrc = Kh + (long)lane * PITCH + wid * 8;
    const bf16_t* vsrc = Vh + (long)(16 * (wid & 3) + (lane >> 2)) * PITCH + (wid >> 2) * 32 + (lane & 3) * 8;
    const unsigned kdst = lds0 + L_K + wid * 1024, vdst = lds0 + L_V + wid * 1024;
#define ATT_DMA_K(t, slot) glds16(ksrc + (long)(t) * KVBLK * PITCH, (unsigned)__builtin_amdgcn_readfirstlane(kdst + (slot)))
#define ATT_DMA_V(t, slot) glds16(vsrc + (long)(t) * KVBLK * PITCH, (unsigned)__builtin_amdgcn_readfirstlane(vdst + (slot)))
    const int vb0 = (int)(lds0 + L_V) + ((lane >> 4) & 1) * 32 + (lane & 3) * 8 + (4 * hi + ((lane & 15) >> 2)) * 64;
    const lds_cptr kp0 = shm3 + L_K + hi * 1024 + r32 * 16;
    const int NT = (q0 + QB) / KVBLK;
    { const float* fcr = FC + (size_t)(b * 8 + h) * SEQ;
      for (int i = tid; i < (q0 + QB) / 4; i += NW * 64) *((__attribute__((address_space(3))) f32x4*)bt + i) = *((const f32x4*)fcr + i); }
    ATT_DMA_K(0, 0); ATT_DMA_V(0, 0); ATT_DMA_K(1, SLOTB); ATT_DMA_V(1, SLOTB); ATT_DMA_K(2, 2 * SLOTB); ATT_DMA_V(2, 2 * SLOTB);
    bf16x8 qr[4];
#pragma unroll
    for (int d0 = 0; d0 < 4; ++d0) qr[d0] = *reinterpret_cast<const bf16x8*>(&Qw[(long)r32 * PITCH + d0 * 16 + hi * 8]);
    float mrun = -INFINITY, l_reg = 0.f; f32x16 o[2]; o[0] = f32x16{}; o[1] = f32x16{};
    const int qabs = q0 + wid * 32 + r32;
    asm volatile("s_waitcnt vmcnt(4) lgkmcnt(0)\n\ts_barrier" ::: "memory");
    for (int t = 0; t < NT; ++t) {
        const int slot = (t & 3) * SLOTB;
        if (t + 3 < NT) { const int ns = ((t + 3) & 3) * SLOTB; ATT_DMA_K(t + 3, ns); ATT_DMA_V(t + 3, ns); }
        if (64 * t <= q0 + wid * 32 + 31) {
            f32x16 p0, p1;
            { const lds_fptr bp = bt + 64 * t + 4 * hi;
#pragma unroll
              for (int g = 0; g < 4; ++g) { const f32x4 a = *(const __attribute__((address_space(3))) f32x4*)(bp + 8 * g), c = *(const __attribute__((address_space(3))) f32x4*)(bp + 32 + 8 * g);
#pragma unroll
                  for (int j = 0; j < 4; ++j) { p0[4 * g + j] = a[j]; p1[4 * g + j] = c[j]; } } }
            const lds_cptr kp = kp0 + slot;
#pragma unroll
            for (int d0 = 0; d0 < 4; ++d0) {
                const bf16x8 b0 = *(const __attribute__((address_space(3))) bf16x8*)(kp + d0 * 2048);
                const bf16x8 b1 = *(const __attribute__((address_space(3))) bf16x8*)(kp + d0 * 2048 + 512);
                p0 = __builtin_amdgcn_mfma_f32_32x32x16_bf16(b0, qr[d0], p0, 0, 0, 0);
                p1 = __builtin_amdgcn_mfma_f32_32x32x16_bf16(b1, qr[d0], p1, 0, 0, 0);
            }
            if (64 * t + 63 > q0 + wid * 32) {
#pragma unroll
                for (int r = 0; r < 16; ++r) { const int kv = 64 * t + crow(r, hi); if (kv > qabs) p0[r] = -INFINITY; if (kv + 32 > qabs) p1[r] = -INFINITY; }
            }
            float rm = p0[0];
#pragma unroll
            for (int r = 1; r < 16; ++r) rm = fmaxf(rm, p0[r]);
#pragma unroll
            for (int r = 0; r < 16; ++r) rm = fmaxf(rm, p1[r]);
            rm = fmaxf(rm, __shfl_xor(rm, 32));
            const float mnew = fmaxf(mrun, rm); const float alpha = __builtin_amdgcn_exp2f(mrun - mnew); mrun = mnew;
            float ls = 0.f;
#pragma unroll
            for (int r = 0; r < 16; ++r) { p0[r] = __builtin_amdgcn_exp2f(p0[r] - mnew); p1[r] = __builtin_amdgcn_exp2f(p1[r] - mnew); ls += p0[r] + p1[r]; }
            l_reg = l_reg * alpha + ls;
            if (hi == 0) wsf[r32] = alpha;
            asm volatile("s_waitcnt lgkmcnt(0)" ::: "memory");
#pragma unroll
            for (int r = 0; r < 16; ++r) { const float f = wsf[crow(r, hi)]; o[0][r] *= f; o[1][r] *= f; }
            u32x4 pw0 = (u32x4){cvtpk_s(p0[0], p0[1]), cvtpk_s(p0[2], p0[3]), cvtpk_s(p0[4], p0[5]), cvtpk_s(p0[6], p0[7])};
            u32x4 pw1 = (u32x4){cvtpk_s(p0[8], p0[9]), cvtpk_s(p0[10], p0[11]), cvtpk_s(p0[12], p0[13]), cvtpk_s(p0[14], p0[15])};
            u32x4 pw2 = (u32x4){cvtpk_s(p1[0], p1[1]), cvtpk_s(p1[2], p1[3]), cvtpk_s(p1[4], p1[5]), cvtpk_s(p1[6], p1[7])};
            u32x4 pw3 = (u32x4){cvtpk_s(p1[8], p1[9]), cvtpk_s(p1[10], p1[11]), cvtpk_s(p1[12], p1[13]), cvtpk_s(p1[14], p1[15])};
            asm volatile("s_waitcnt lgkmcnt(0)" ::: "memory");
            pv(o, vb0 + slot, __builtin_bit_cast(bf16x8, pw0), __builtin_bit_cast(bf16x8, pw1), __builtin_bit_cast(bf16x8, pw2), __builtin_bit_cast(bf16x8, pw3));
        }
        if (t + 3 < NT) asm volatile("s_waitcnt vmcnt(4) lgkmcnt(0)\n\ts_barrier" ::: "memory");
        else if (t + 2 < NT) asm volatile("s_waitcnt vmcnt(2) lgkmcnt(0)\n\ts_barrier" ::: "memory");
        else ATT_WAIT_BAR();
    }
    l_reg += __shfl_xor(l_reg, 32);
    if (hi == 0) wsf[32 + r32] = l_reg;
    asm volatile("s_waitcnt lgkmcnt(0)" ::: "memory");
    float rli[16];
#pragma unroll
    for (int r = 0; r < 16; ++r) rli[r] = __builtin_amdgcn_rcpf(wsf[32 + crow(r, hi)]);
    bf16_t* Ow = CAT + (rowbase + q0 + wid * 32) * PITCH + 512 + h * 64;
    { __attribute__((address_space(3))) bf16_t* stg = (__attribute__((address_space(3))) bf16_t*)(shm3 + L_OST) + wid * 2048;
#pragma unroll
      for (int r = 0; r < 16; ++r) { const int orow = crow(r, hi);
#pragma unroll
          for (int d0 = 0; d0 < 2; ++d0) stg[orow * 64 + d0 * 32 + r32] = (bf16_t)(cvtpk_s(o[d0][r] * rli[r], 0.f) & 0xffffu); }
      asm volatile("s_waitcnt lgkmcnt(0)" ::: "memory");
#pragma unroll
      for (int i = 0; i < 4; ++i) { const int row = i * 8 + (lane >> 3), ch = lane & 7; const u32x4 v = *(const __attribute__((address_space(3))) u32x4*)(stg + row * 64 + ch * 8); *(u32x4*)(Ow + (long)row * PITCH + ch * 8) = v; } }
    asm volatile("s_waitcnt lgkmcnt(0)\n\ts_barrier" ::: "memory");
#undef ATT_DMA_K
#undef ATT_DMA_V
}
#undef ATT_WAIT_BAR
}
#include <hip/hip_bf16.h>
#include <cmath>
namespace attn_body {
using bf16=__hip_bfloat16;
using bf16x8=__attribute__((ext_vector_type(8)))short;
using s16x4=__attribute__((ext_vector_type(4)))short;
using f32x16=__attribute__((ext_vector_type(16)))float;
using u32x4=__attribute__((ext_vector_type(4)))unsigned;
using u32x2=__attribute__((ext_vector_type(2)))unsigned;
constexpr int BATCH=8,SEQ=4096,D=64,DM=1024;
constexpr int NW=8,QBLK=32,QB=QBLK*NW,KVBLK=64,NQB=SEQ/QB;
constexpr int ATTN_PITCH=DM, ATTN_UNIT_ROWS=QB;
__device__ __forceinline__ int crow(int r,int hi){return (r&3)+8*(r>>2)+4*hi;}
#define SBAR() __builtin_amdgcn_sched_barrier(0)
__device__ __forceinline__ void cmask(f32x16&p0,f32x16&p1,int jb,int qrel,int hi){
  asm volatile("":"+v"(hi));
  const float NEG=-INFINITY; int kb=64*jb+4*hi;
  #pragma unroll
  for(int r=0;r<16;++r){int kv=kb+(r&3)+8*(r>>2); if(kv>qrel)p0[r]=NEG; if(kv+32>qrel)p1[r]=NEG;}
}

constexpr int NSLOT=3, SLOTB=8192;
constexpr int LDS_K=0, LDS_V=NSLOT*SLOTB, LDS_WS=2*NSLOT*SLOTB, LDS_OST=LDS_WS+NW*64*4, LDS_BIAS=LDS_OST+NW*4096, LDS_BYTES=LDS_BIAS+SEQ*8;
constexpr float C2=0.125f*1.4426950408889634f;
__device__ __forceinline__ void glds16(const void*gsrc,unsigned lds_dst){unsigned keep;
  asm volatile("s_mov_b32 %0, m0\n\ts_mov_b32 m0, %2\n\ts_nop 0\n\tglobal_load_lds_dwordx4 %1, off\n\ts_mov_b32 m0, %0":"=&s"(keep):"v"(gsrc),"s"(lds_dst):"memory");}
__device__ __forceinline__ float max3f(float a,float b,float c){float r;asm("v_max3_f32 %0, %1, %2, %3":"=v"(r):"v"(a),"v"(b),"v"(c));return r;}
__device__ __forceinline__ float max2f(float a,float b){float r;asm("v_max_f32_e32 %0, %1, %2":"=v"(r):"v"(a),"v"(b));return r;}
__device__ __forceinline__ float fadd_s(float a,float b){float r;asm("v_add_f32_e32 %0, %1, %2":"=v"(r):"v"(a),"v"(b));return r;}
__device__ __forceinline__ float fsub_s(float a,float b){float r;asm("v_sub_f32_e32 %0, %1, %2":"=v"(r):"v"(a),"v"(b));return r;}
typedef float f32x2_t __attribute__((ext_vector_type(2))); typedef __bf16 bf16x2_t __attribute__((ext_vector_type(2)));
__device__ __forceinline__ unsigned cvtpk_s(float lo,float hi){f32x2_t v={lo,hi};bf16x2_t b=__builtin_convertvector(v,bf16x2_t);return __builtin_bit_cast(unsigned,b);}
#define WAIT_BAR(N) asm volatile("s_waitcnt vmcnt(" #N ") lgkmcnt(0)\n\ts_barrier":::"memory")

__device__ __forceinline__ void qkt(f32x16&p0,f32x16&p1,const char*Kslot,const bf16x8*qr,int r32,int hi){
  const char*kb=Kslot+hi*1024+r32*16;
  #pragma unroll
  for(int d0=0;d0<4;++d0){
    const bf16x8 b0=*reinterpret_cast<const bf16x8*>(kb+d0*2048);
    const bf16x8 b1=*reinterpret_cast<const bf16x8*>(kb+d0*2048+512);
    {p0=__builtin_amdgcn_mfma_f32_32x32x16_bf16(b0,qr[d0],p0,0,0,0);p1=__builtin_amdgcn_mfma_f32_32x32x16_bf16(b1,qr[d0],p1,0,0,0);}}
}
typedef __attribute__((address_space(3))) const char* lds_cptr;
typedef short v4i16_t __attribute__((ext_vector_type(4)));
__device__ __forceinline__ void kload8(bf16x8*kf,lds_cptr kp){
  kf[0]=*(const __attribute__((address_space(3))) bf16x8*)(kp);      kf[1]=*(const __attribute__((address_space(3))) bf16x8*)(kp+512);
  kf[2]=*(const __attribute__((address_space(3))) bf16x8*)(kp+2048); kf[3]=*(const __attribute__((address_space(3))) bf16x8*)(kp+2560);
  kf[4]=*(const __attribute__((address_space(3))) bf16x8*)(kp+4096); kf[5]=*(const __attribute__((address_space(3))) bf16x8*)(kp+4608);
  kf[6]=*(const __attribute__((address_space(3))) bf16x8*)(kp+6144); kf[7]=*(const __attribute__((address_space(3))) bf16x8*)(kp+6656);
}
__device__ __forceinline__ void kload2(bf16x8*kf,lds_cptr kp,int j){ kf[2*j]=*(const __attribute__((address_space(3))) bf16x8*)(kp+j*2048); kf[2*j+1]=*(const __attribute__((address_space(3))) bf16x8*)(kp+j*2048+512); }
__device__ __forceinline__ s16x4 vtr(lds_cptr p){ return __builtin_bit_cast(s16x4,__builtin_amdgcn_ds_read_tr16_b64_v4i16((__attribute__((address_space(3))) v4i16_t*)p)); }
__device__ __forceinline__ float rowmax(const f32x16&p0,const f32x16&p1){
  float a=max3f(p0[0],p0[1],p1[0]),b=max3f(p0[2],p0[3],p1[1]);a=max3f(a,p1[2],p1[3]);
  #pragma unroll
  for(int r=4;r<16;r+=4){a=max3f(a,p0[r],p0[r+1]);b=max3f(b,p0[r+2],p0[r+3]);a=max3f(a,p1[r],p1[r+1]);b=max3f(b,p1[r+2],p1[r+3]);}
  const float m=max2f(a,b);
  auto rr=__builtin_amdgcn_permlane32_swap(__float_as_uint(m),__float_as_uint(m),false,false);
  return max2f(__uint_as_float(rr[0]),__uint_as_float(rr[1]));
}
__device__ __forceinline__ void pv(f32x16*o,int vb,bf16x8 pa0,bf16x8 pa1,bf16x8 pa2,bf16x8 pa3){
  #pragma unroll
  for(int d0=0;d0<2;++d0){s16x4 lo[4],hi[4];
    #pragma unroll
    for(int ks=0;ks<4;++ks){
      asm volatile("ds_read_b64_tr_b16 %0,%1 offset:%c2":"=&v"(lo[ks]):"v"(vb),"i"(d0*4096+ks*1024):"memory");
      asm volatile("ds_read_b64_tr_b16 %0,%1 offset:%c2":"=&v"(hi[ks]):"v"(vb),"i"(d0*4096+ks*1024+512):"memory");}
    asm volatile("s_waitcnt lgkmcnt(0)":::"memory");SBAR();
    #define PK(k) (bf16x8){lo[k][0],lo[k][1],lo[k][2],lo[k][3],hi[k][0],hi[k][1],hi[k][2],hi[k][3]}
    o[d0]=__builtin_amdgcn_mfma_f32_32x32x16_bf16(pa0,PK(0),o[d0],0,0,0);
    o[d0]=__builtin_amdgcn_mfma_f32_32x32x16_bf16(pa1,PK(1),o[d0],0,0,0);
    o[d0]=__builtin_amdgcn_mfma_f32_32x32x16_bf16(pa2,PK(2),o[d0],0,0,0);
    o[d0]=__builtin_amdgcn_mfma_f32_32x32x16_bf16(pa3,PK(3),o[d0],0,0,0);
    #undef PK
  }
}

#ifndef ATTN_STORE16
#define ATTN_STORE16(p,v) (*(u32x4*)(p)=(v))
#endif
template<int THRL> __device__ __forceinline__ void attn_unit(int b,int h,int qb,const bf16*Q,const bf16*__restrict__ K,const bf16*__restrict__ V,bf16*O,const u32x4*__restrict__ FC8row,int js,char*shm){
  const int tid=threadIdx.x,lane=tid&63,r32=lane&31,hi=lane>>5; const int wid=__builtin_amdgcn_readfirstlane(tid>>6);
  const long rowbase=(long)b*SEQ; const int q0=qb*QB;
  const bf16*Qw=Q+(rowbase+q0+wid*QBLK)*DM+h*D;
  const bf16*Kh=K+(rowbase+(long)js*KVBLK)*DM+h*D,*Vh=V+(rowbase+(long)js*KVBLK)*DM+h*D; FC8row+=js*(KVBLK/2);
  const unsigned lds0=(unsigned)(uintptr_t)shm;
  float*wsf=(float*)(shm+LDS_WS)+wid*64;
  typedef __attribute__((address_space(3))) u32x4* lds_u4ptr; typedef __attribute__((address_space(3))) const u32x2* lds_u2cptr;
  const lds_u2cptr bt8=(lds_u2cptr)((__attribute__((address_space(3))) const char*)shm+LDS_BIAS)+r32;
  unsigned bm1=hi?0u:0x00003F80u, bm2=0u; const unsigned bm0=hi?0u:0x3F803F80u; u32x2 ab0,ab1;
  #define BFRAG() __builtin_bit_cast(bf16x8,(u32x4){bm0,bm1,bm2,0u})
  #define AFRAG(e) __builtin_bit_cast(bf16x8,(u32x4){e[0],e[1],0x3F803F80u,0u})
  #define ABLD(t) do{ ab0=bt8[64*(t)]; ab1=bt8[64*(t)+32]; }while(0)
  #define SETB() do{ const float m_=-mhat; const unsigned h_=cvtpk_s(m_,0.f)&0xffffu; const float r1_=m_-__uint_as_float(h_<<16); const unsigned d_=cvtpk_s(r1_,0.f)&0xffffu; \
      const float r2_=r1_-__uint_as_float(d_<<16); const unsigned l_=cvtpk_s(r2_,0.f)&0xffffu; bm1=hi?0u:((h_<<16)|0x3F80u); bm2=hi?0u:((l_<<16)|d_); }while(0)
  const bf16*ksrc=Kh+(long)lane*DM+wid*8;
  const bf16*vsrc=Vh+(long)(16*(wid&3)+(lane>>2))*DM+(wid>>2)*32+(lane&3)*8;
  const unsigned kdst=lds0+LDS_K+wid*1024, vdst=lds0+LDS_V+wid*1024;
  #define DMA_K(t,slot) glds16(ksrc+(long)(t)*KVBLK*DM,(unsigned)__builtin_amdgcn_readfirstlane(kdst+(slot)))
  #define DMA_V(t,slot) glds16(vsrc+(long)(t)*KVBLK*DM,(unsigned)__builtin_amdgcn_readfirstlane(vdst+(slot)))
  const int vb0=(int)(lds0+LDS_V)+((lane>>4)&1)*32+(lane&3)*8+(4*hi+((lane&15)>>2))*64;
  const char*Kbase=shm+LDS_K; bf16x8 kf[8];
  const lds_cptr shm3=(lds_cptr)shm; const lds_cptr kp0=shm3+LDS_K+hi*1024+r32*16; const lds_cptr vp0=shm3+LDS_V+((lane>>4)&1)*32+(lane&3)*8+(4*hi+((lane&15)>>2))*64;
  const int NT=(q0+QB)/KVBLK-js;
  DMA_K(0,0);DMA_V(0,0);DMA_K(1,SLOTB);
  bf16x8 qr[4];
  #pragma unroll
  for(int d0=0;d0<4;++d0)qr[d0]=*reinterpret_cast<const bf16x8*>(&Qw[(long)r32*DM+d0*16+hi*8]);
  float mhat=0.f,l_reg=0.f;f32x16 o[2];o[0]=f32x16{};o[1]=f32x16{};const f32x16 zero16=f32x16{};
  const int qrel=wid*QBLK+r32;
  #define CMASK(P0,P1,t) do{int jb_=(t)-(NT-4); if(jb_>=0)cmask(P0,P1,jb_,qrel,hi);}while(0)
  bool resc=false;
  #define START(P0,P1) do{ const float rm=rowmax(P0,P1); resc=false; \
    { const float dl=rm; mhat=fadd_s(mhat,dl); \
      _Pragma("unroll") for(int r=0;r<16;++r){P0[r]=fsub_s(P0[r],dl);P1[r]=fsub_s(P1[r],dl);} \
      SETB(); } \
    _Pragma("unroll") for(int r=0;r<16;++r)P0[r]=__builtin_amdgcn_exp2f(P0[r]); }while(0)
  #define RESC() do{ if(resc){ asm volatile("s_waitcnt lgkmcnt(0)":::"memory"); \
      _Pragma("unroll") for(int d_=0;d_<2;++d_) _Pragma("unroll") for(int r=0;r<16;++r)o[d_][r]*=wsf[crow(r,hi)]; } }while(0)
  f32x16 pA0,pA1,pB0,pB1;
  int sl_prev=0,sl_cur=0,sl_next=SLOTB;
  #define ROT() do{sl_prev=sl_cur;sl_cur=sl_next;sl_next=(sl_next==(NSLOT-1)*SLOTB)?0:sl_next+SLOTB;}while(0)
  DMA_K(2,2*SLOTB);
    { const lds_u4ptr bt16=(lds_u4ptr)((__attribute__((address_space(3))) char*)shm+LDS_BIAS); int t0_=tid; asm volatile("":"+v"(t0_));   for(int i_=t0_;i_<((q0+QB)/KVBLK-js)*(KVBLK/2);i_+=NW*64) bt16[i_]=FC8row[i_]; }
  WAIT_BAR(3);
  ABLD(0); pA0=__builtin_amdgcn_mfma_f32_32x32x16_bf16(AFRAG(ab0),BFRAG(),zero16,0,0,0); pA1=__builtin_amdgcn_mfma_f32_32x32x16_bf16(AFRAG(ab1),BFRAG(),zero16,0,0,0);
  qkt(pA0,pA1,Kbase,qr,r32,hi);asm volatile("s_nop 15\n\ts_nop 7":"+v"(pA0),"+v"(pA1));CMASK(pA0,pA1,0);
  START(pA0,pA1);
  ABLD(1);
  _Pragma("unroll") for(int r=0;r<16;++r)pA1[r]=__builtin_amdgcn_exp2f(pA1[r]);
  WAIT_BAR(0);
  DMA_K(3,0);DMA_V(1,SLOTB);
  ROT();
  kload8(kf,kp0+sl_cur);
  WAIT_BAR(2);
  s16x4 vlo[8],vhi[8]; u32x4 pw0,pw1,pw2,pw3;
  #define PKW(P,B) cvtpk_s(P[B],P[B+1])
  #define PAF(k) __builtin_bit_cast(bf16x8,pw##k)
  #define VFR(i) (bf16x8){vlo[i][0],vlo[i][1],vlo[i][2],vlo[i][3],vhi[i][0],vhi[i][1],vhi[i][2],vhi[i][3]}
  #define PIN(x) asm volatile("":"+v"(x))
  #define MX3(a,b,c) __builtin_fmaxf(__builtin_fmaxf((a),(b)),(c))
  #define GAPA(MF,A0,A1,A2,A3,W0,W1,PW) do{ MF; sacc+=A0; sacc+=A1; sacc+=A2; sacc+=A3; PIN(sacc); W0; W1; PIN(PW); SBAR(); }while(0)
  #define EX(v) __builtin_amdgcn_exp2f(v)
  #define GAPB(MF,X,B) do{ MF; X[B]=EX(X[B]); X[B+1]=EX(X[B+1]); X[B+2]=EX(X[B+2]); X[B+3]=EX(X[B+3]); PIN(X); SBAR(); }while(0)
  #define VRD(i) do{ vlo[i]=vtr(vp_+(((i)>>2)*4096+((i)&3)*1024)); vhi[i]=vtr(vp_+(((i)>>2)*4096+((i)&3)*1024+512)); }while(0)
  #define KRD(G,j) do{ if(G){ kload2(kf,kp0+sl_next,j); SBAR(); } }while(0)
  #define STEP(C0,C1,P0,P1,t,GK,GV,GL) do{ SBAR(); \
    const lds_cptr vp_=vp0+sl_prev; \
    C0=__builtin_amdgcn_mfma_f32_32x32x16_bf16(AFRAG(ab0),BFRAG(),zero16,0,0,0); C1=__builtin_amdgcn_mfma_f32_32x32x16_bf16(AFRAG(ab1),BFRAG(),zero16,0,0,0); \
    VRD(0); SBAR(); float sacc=(P0[0]+P0[1]); \
    GAPA(C0=__builtin_amdgcn_mfma_f32_32x32x16_bf16(kf[0],qr[0],C0,0,0,0), P0[2],P0[3],P0[4],P0[5],     pw0[0]=PKW(P0,0), pw0[1]=PKW(P0,2), pw0); \
    VRD(4); SBAR(); GAPA(C1=__builtin_amdgcn_mfma_f32_32x32x16_bf16(kf[1],qr[0],C1,0,0,0), P0[6],P0[7],P0[8],P0[9],     pw0[2]=PKW(P0,4), pw0[3]=PKW(P0,6), pw0); \
    VRD(1); SBAR(); GAPA(C0=__builtin_amdgcn_mfma_f32_32x32x16_bf16(kf[2],qr[1],C0,0,0,0),   P0[10],P0[11],P0[12],P0[13], pw1[0]=PKW(P0,8), pw1[1]=PKW(P0,10), pw1); \
    VRD(5); SBAR(); GAPA(C1=__builtin_amdgcn_mfma_f32_32x32x16_bf16(kf[3],qr[1],C1,0,0,0),   P0[14],P0[15],P1[0],P1[1],   pw1[2]=PKW(P0,12),pw1[3]=PKW(P0,14), pw1); \
    VRD(2); SBAR(); GAPA(C0=__builtin_amdgcn_mfma_f32_32x32x16_bf16(kf[4],qr[2],C0,0,0,0),   P1[2],P1[3],P1[4],P1[5],     pw2[0]=PKW(P1,0), pw2[1]=PKW(P1,2), pw2); \
    VRD(6); SBAR(); GAPA(C1=__builtin_amdgcn_mfma_f32_32x32x16_bf16(kf[5],qr[2],C1,0,0,0),   P1[6],P1[7],P1[8],P1[9],     pw2[2]=PKW(P1,4), pw2[3]=PKW(P1,6), pw2); \
    VRD(3); SBAR(); GAPA(C0=__builtin_amdgcn_mfma_f32_32x32x16_bf16(kf[6],qr[3],C0,0,0,0),   P1[10],P1[11],P1[12],P1[13], pw3[0]=PKW(P1,8), pw3[1]=PKW(P1,10), pw3); \
    VRD(7); SBAR(); GAPA(C1=__builtin_amdgcn_mfma_f32_32x32x16_bf16(kf[7],qr[3],C1,0,0,0),   P1[14],P1[15],0.f,0.f,       pw3[2]=PKW(P1,12),pw3[3]=PKW(P1,14), pw3); \
    l_reg+=sacc; \
    if(GK){DMA_K((t)+3,sl_cur);} if(GV){DMA_V((t)+1,sl_next);} \
    CMASK(C0,C1,t); \
    { float a=MX3(C0[0],C0[1],C1[0]),b=MX3(C0[2],C0[3],C1[1]); a=MX3(a,C1[2],C1[3]); \
      _Pragma("unroll") for(int r=4;r<16;r+=4){a=MX3(a,C0[r],C0[r+1]);b=MX3(b,C0[r+2],C0[r+3]);a=MX3(a,C1[r],C1[r+1]);b=MX3(b,C1[r+2],C1[r+3]);} \
      float rm=__builtin_fmaxf(a,b); { auto rr=__builtin_amdgcn_permlane32_swap(__float_as_uint(rm),__float_as_uint(rm),false,false); rm=__builtin_fmaxf(__uint_as_float(rr[0]),__uint_as_float(rr[1])); } \
      resc=false; \
      if(__builtin_expect(__any(rm>(float)THRL),0)){ const float dl=__builtin_fmaxf(rm,0.f); mhat+=dl; \
        _Pragma("unroll") for(int r=0;r<16;++r){C0[r]-=dl;C1[r]-=dl;} \
        SETB(); \
        const float f=__builtin_amdgcn_exp2f(-dl); l_reg*=f; if(hi==0)wsf[r32]=f; resc=true; } } \
    if(GL){ ABLD((t)+1); } \
    SBAR(); \
    GAPB(o[0]=__builtin_amdgcn_mfma_f32_32x32x16_bf16(PAF(0),VFR(0),o[0],0,0,0), C0,0); \
    GAPB(o[1]=__builtin_amdgcn_mfma_f32_32x32x16_bf16(PAF(0),VFR(4),o[1],0,0,0), C0,4); \
    KRD(GL,0); GAPB(o[0]=__builtin_amdgcn_mfma_f32_32x32x16_bf16(PAF(1),VFR(1),o[0],0,0,0), C0,8); \
    KRD(GL,1); GAPB(o[1]=__builtin_amdgcn_mfma_f32_32x32x16_bf16(PAF(1),VFR(5),o[1],0,0,0), C0,12); \
    KRD(GL,2); GAPB(o[0]=__builtin_amdgcn_mfma_f32_32x32x16_bf16(PAF(2),VFR(2),o[0],0,0,0), C1,0); \
    KRD(GL,3); GAPB(o[1]=__builtin_amdgcn_mfma_f32_32x32x16_bf16(PAF(2),VFR(6),o[1],0,0,0), C1,4); \
    GAPB(o[0]=__builtin_amdgcn_mfma_f32_32x32x16_bf16(PAF(3),VFR(3),o[0],0,0,0), C1,8); \
    GAPB(o[1]=__builtin_amdgcn_mfma_f32_32x32x16_bf16(PAF(3),VFR(7),o[1],0,0,0), C1,12); \
    }while(0)
  int t=1;
  #undef CMASK
  #define CMASK(P0,P1,t) do{}while(0)
  for(;t+5<NT;t+=2){
    STEP(pB0,pB1,pA0,pA1,t,true,true,true);     WAIT_BAR(2); RESC(); ROT();
    STEP(pA0,pA1,pB0,pB1,t+1,true,true,true);   WAIT_BAR(2); RESC(); ROT();
  }
  #undef CMASK
  #define CMASK(P0,P1,t) do{int jb_=(t)-(NT-4); if(jb_>=0)cmask(P0,P1,jb_,qrel,hi);}while(0)
  #define ENDW(tt) do{ if((tt)+3<NT){WAIT_BAR(2);} else if((tt)+2<NT){WAIT_BAR(1);} else {WAIT_BAR(0);} }while(0)
  for(;t+1<NT;t+=2){
    STEP(pB0,pB1,pA0,pA1,t,(t+3<NT),(t+1<NT),(t+1<NT));       ENDW(t);   RESC(); ROT();
    STEP(pA0,pA1,pB0,pB1,t+1,(t+4<NT),(t+2<NT),(t+2<NT));     ENDW(t+1); RESC(); ROT();
  }
  STEP(pB0,pB1,pA0,pA1,NT-1,false,false,false); RESC();
  { float sacc=pB0[0]+pB0[1]; _Pragma("unroll") for(int r=2;r<16;++r)sacc+=pB0[r]; _Pragma("unroll") for(int r=0;r<16;++r)sacc+=pB1[r]; l_reg+=sacc;
    pw0=(u32x4){PKW(pB0,0),PKW(pB0,2),PKW(pB0,4),PKW(pB0,6)};pw1=(u32x4){PKW(pB0,8),PKW(pB0,10),PKW(pB0,12),PKW(pB0,14)};pw2=(u32x4){PKW(pB1,0),PKW(pB1,2),PKW(pB1,4),PKW(pB1,6)};pw3=(u32x4){PKW(pB1,8),PKW(pB1,10),PKW(pB1,12),PKW(pB1,14)};
    SBAR(); pv(o,vb0+sl_cur,PAF(0),PAF(1),PAF(2),PAF(3)); }
  #undef PKW
  #undef PAF
  #undef VFR
  #undef PIN
  #undef MX3
  #undef GAPA
  #undef GAPB
  #undef EX
  #undef VRD
  #undef KRD
  #undef STEP
  #undef ENDW
  {auto rr=__builtin_amdgcn_permlane32_swap(__float_as_uint(l_reg),__float_as_uint(l_reg),false,false);l_reg=__uint_as_float(rr[0])+__uint_as_float(rr[1]);}
  if(hi==0)wsf[32+r32]=l_reg;asm volatile("s_waitcnt lgkmcnt(0)":::"memory");
  float rli[16];
  #pragma unroll
  for(int r=0;r<16;++r)rli[r]=__builtin_amdgcn_rcpf(wsf[32+crow(r,hi)]);
  bf16*Ow=O+(rowbase+q0+wid*QBLK)*DM+h*D;
  { bf16*stg=(bf16*)(shm+LDS_OST)+wid*2048;
    #pragma unroll
    for(int r=0;r<16;++r){const int orow=crow(r,hi);
      #pragma unroll
      for(int d0=0;d0<2;++d0)stg[orow*64+d0*32+r32]=__float2bfloat16(o[d0][r]*rli[r]);}
    asm volatile("s_waitcnt lgkmcnt(0)":::"memory");
    #pragma unroll
    for(int i=0;i<4;++i){const int row=i*8+(lane>>3),ch=lane&7; const u32x4 v=*(const u32x4*)(stg+row*64+ch*8); ATTN_STORE16(Ow+(long)row*DM+ch*8,v);} }
  asm volatile("s_waitcnt lgkmcnt(0)\n\ts_barrier":::"memory");
  #undef DMA_K
  #undef DMA_V
  #undef BFRAG
  #undef AFRAG
  #undef ABLD
  #undef SETB
  #undef CMASK
  #undef START
  #undef RESC
  #undef ROT
}
constexpr int ATTN_LDS_BYTES=LDS_BYTES;
#undef SBAR
#undef WAIT_BAR
}
constexpr int NWAVES = 8;
constexpr int TOK = 8 * 4096, DM = 1024, DFF = 2816, SEQL = 4096;
constexpr int N_GU = 2 * DFF, N_EVIN = 2560  , N_ODIN = 3072;
constexpr size_t MiB = 1u << 20;
constexpr size_t GU_BYTES = (size_t)N_GU * DM * 2, DN_BYTES = (size_t)DM * DFF * 2;
constexpr size_t WS_WGU = 2 * MiB;
constexpr size_t WS_WDN = WS_WGU + 4 * GU_BYTES;
constexpr size_t WS_WEVIN = WS_WDN + 4 * DN_BYTES;
constexpr size_t WS_WEVOUT = WS_WEVIN + (size_t)N_EVIN * DM * 2;
constexpr size_t WS_WODIN = WS_WEVOUT + (size_t)DM * DM * 2;
constexpr size_t WS_WODOUT = WS_WODIN + (size_t)N_ODIN * DM * 2;
constexpr size_t WS_WEND = WS_WODOUT + (size_t)DM * DM * 2;
static_assert(WS_WEND <= 88 * MiB, "weights");
constexpr size_t WS_SSP = 88 * MiB;
constexpr size_t WS_LF = 90 * MiB, WS_FC = 91 * MiB;
constexpr size_t WS_FC8 = 92 * MiB;
constexpr size_t WS_XB = 96 * MiB;
constexpr size_t WS_H = 160 * MiB;
constexpr size_t WS_QK = 160 * MiB, WS_VA = 224 * MiB, WS_CAT = 288 * MiB;
constexpr size_t WS_END = 352 * MiB;
constexpr int LDS_BYTES = 147456;
constexpr int MISC_OFF = 131072 + 320;
constexpr size_t WS_CTL = 0, CTL_ZERO_BYTES = 65536; constexpr int CW_BAR = 4096; constexpr int CW_QUEUE = 8192;
constexpr int N_PHASES = 16;

#define GAS __attribute__((address_space(1)))
#define LAS __attribute__((address_space(3)))
typedef unsigned short bf16;
typedef unsigned v4u __attribute__((ext_vector_type(4)));
typedef float f32x4 __attribute__((ext_vector_type(4)));
#define LDS_WAIT() asm volatile("s_waitcnt lgkmcnt(0)" ::: "memory")
__device__ __forceinline__ unsigned pk2(float lo, float hi) { return pg8::cvt_pk_bf16(lo, hi); }
__device__ __forceinline__ float bf_lo(unsigned w) { return __uint_as_float(w << 16); }
__device__ __forceinline__ float bf_hi(unsigned w) { return __uint_as_float(w & 0xffff0000u); }
__device__ __forceinline__ float wave_sum(float v) {
#pragma unroll
    for (int o = 1; o < 64; o <<= 1) v += __shfl_xor(v, o);
    return v;
}

struct Args { const float* in[21]; float* out; unsigned char* ws; int ph_lo, ph_hi; };
struct P0Item { const float* src; const float* gain; bf16* dst; int N, col0, nvalid, K, drow0, k0; };
__device__ __forceinline__ void p0_load(const P0Item& d, f32x4 (&v)[8], int lane) {
    const int kr = lane >> 3, c4 = (lane & 7) * 4;
#pragma unroll
    for (int i = 0; i < 8; ++i) { const int kk = 8 * i + kr; v[i] = (f32x4){0.f, 0.f, 0.f, 0.f};
        if (c4 < d.nvalid) { v[i] = __builtin_nontemporal_load((const f32x4*)(d.src + (size_t)(d.k0 + kk) * d.N + d.col0 + c4)); if (d.gain) v[i] = v[i] * d.gain[d.k0 + kk]; } }
}
__device__ __forceinline__ void p0_store(const P0Item& d, const f32x4 (&v)[8], LAS float* scr, int lane) {
    const int kr = lane >> 3, c4 = (lane & 7) * 4;
#pragma unroll
    for (int i = 0; i < 8; ++i) { LAS float* s = scr + (8 * i + kr) * 33 + c4; s[0] = v[i][0]; s[1] = v[i][1]; s[2] = v[i][2]; s[3] = v[i][3]; }
    LDS_WAIT(); asm volatile("" ::: "memory");
    const int c8 = lane & 7;
#pragma unroll
    for (int j = 0; j < 4; ++j) { const int n = (lane >> 3) + 8 * j; const LAS float* s = scr + (8 * c8) * 33 + n;
        v4u o; o.x = pk2(s[0 * 33], s[1 * 33]); o.y = pk2(s[2 * 33], s[3 * 33]); o.z = pk2(s[4 * 33], s[5 * 33]); o.w = pk2(s[6 * 33], s[7 * 33]);
        *(v4u*)(d.dst + (size_t)(d.drow0 + n) * d.K + d.k0 + 8 * c8) = o; }
    LDS_WAIT(); asm volatile("" ::: "memory");
}
constexpr int I_GU = (DM / 64) * (N_GU / 32), I_DN = (DFF / 64) * (DM / 32), I_EVIN = (DM / 64) * (N_EVIN / 32), I_OUT = (DM / 64) * (DM / 32), I_ODIN = (DM / 64) * (N_ODIN / 32);
constexpr int P0_NITEMS = 4 * I_GU + 4 * I_DN + I_EVIN + I_OUT + I_ODIN + I_OUT;
__device__ __forceinline__ P0Item p0_decode(const Args& A, int it) {
    unsigned char* ws = A.ws; P0Item d; int r = it; d.nvalid = 32; d.gain = nullptr; d.K = DM;
    if (r < 4 * I_GU) { const int w = r / I_GU; r -= w * I_GU; const int layer = w >> 1, second = w & 1;
        const int nbn = N_GU / 32, kb = r / nbn, nb = r % nbn, pn = nb >> 3, bj = (nb >> 2) & 1, c0 = (nb & 3) * 32;
        const float* gsrc = second ? A.in[7] : A.in[2]; const float* usrc = second ? A.in[8] : A.in[3]; const float* nsrc = second ? A.in[6] : A.in[1];
        d.src = (bj ? usrc : gsrc) + (size_t)layer * DM * DFF; d.gain = nsrc + layer * DM; d.N = DFF; d.col0 = 128 * pn + c0;
        d.dst = (bf16*)(ws + WS_WGU + w * GU_BYTES); d.drow0 = 32 * nb; d.k0 = 64 * kb; return d; }
    r -= 4 * I_GU;
    if (r < 4 * I_DN) { const int w = r / I_DN; r -= w * I_DN; const int layer = w >> 1, second = w & 1;
        const int nbn = DM / 32, kb = r / nbn, nb = r % nbn;
        d.src = (second ? A.in[9] : A.in[4]) + (size_t)layer * DFF * DM; d.N = DM; d.col0 = 32 * nb; d.K = DFF;
        d.dst = (bf16*)(ws + WS_WDN + w * DN_BYTES); d.drow0 = 32 * nb; d.k0 = 64 * kb; return d; }
    r -= 4 * I_DN;
    if (r < I_EVIN) { const int nbn = N_EVIN / 32, kb = r / nbn, nb = r % nbn, pn = nb >> 3, bj = (nb >> 2) & 1, wc = nb & 3; int col0;
        if (pn < 4) col0 = (bj ? 512 : 0) + 128 * pn + 32 * wc;
        else if (pn < 8) col0 = (pn < 6 ? 1024 : 1536) + (4 * (pn & 1) + wc) * 64 + 32 * bj;
        else if (pn < 10) col0 = 2048 + 256 * (pn - 8) + 128 * bj + 32 * wc;
        else { col0 = 2560; d.nvalid = (nb == 80) ? 8 : 0; }
        d.src = A.in[10]; d.gain = A.in[5]; d.N = 2568; d.col0 = col0; d.dst = (bf16*)(ws + WS_WEVIN); d.drow0 = 32 * nb; d.k0 = 64 * kb; return d; }
    r -= I_EVIN;
    if (r < I_OUT) { const int nbn = DM / 32, kb = r / nbn, nb = r % nbn;
        d.src = A.in[17]; d.N = DM; d.col0 = 32 * nb; d.dst = (bf16*)(ws + WS_WEVOUT); d.drow0 = 32 * nb; d.k0 = 64 * kb; return d; }
    r -= I_OUT;
    if (r < I_ODIN) { const int nbn = N_ODIN / 32, kb = r / nbn, nb = r % nbn, pn = nb >> 3, bj = (nb >> 2) & 1, wc = nb & 3;
        d.col0 = (pn < 8) ? (bj ? 2048 : 1024) + 128 * pn + 32 * wc : 256 * (pn - 8) + 128 * bj + 32 * wc;
        d.src = A.in[18]; d.gain = A.in[5] + DM; d.N = N_ODIN; d.dst = (bf16*)(ws + WS_WODIN); d.drow0 = 32 * nb; d.k0 = 64 * kb; return d; }
    r -= I_ODIN;
    { const int nbn = DM / 32, kb = r / nbn, nb = r % nbn;
        d.src = A.in[20]; d.N = DM; d.col0 = 32 * nb; d.dst = (bf16*)(ws + WS_WODOUT); d.drow0 = 32 * nb; d.k0 = 64 * kb; return d; }
}

constexpr int P0_EARLY = I_GU + I_DN, SHADOW_N = P0_NITEMS - P0_EARLY, SHADOW_PER_SEAM = 256 * (NWAVES - 1);
__device__ __forceinline__ int early_item_id(int j) { return j < I_GU ? j : 4 * I_GU + (j - I_GU); }
__device__ __forceinline__ int shadow_item_id(int j) {
    constexpr int B0 = 4 * I_GU + 4 * I_DN;
    if (j < I_EVIN) return B0 + j; j -= I_EVIN;
    if (j < I_OUT) return B0 + I_EVIN + j; j -= I_OUT;
    if (j < I_GU) return I_GU + j; j -= I_GU;
    if (j < I_DN) return 4 * I_GU + I_DN + j; j -= I_DN;
    if (j < I_GU) return 2 * I_GU + j; j -= I_GU;
    if (j < I_DN) return 4 * I_GU + 2 * I_DN + j; j -= I_DN;
    if (j < I_ODIN) return B0 + I_EVIN + I_OUT + j; j -= I_ODIN;
    if (j < I_OUT) return B0 + I_EVIN + I_OUT + I_ODIN + j; j -= I_OUT;
    if (j < I_GU) return 3 * I_GU + j; j -= I_GU;
    return 4 * I_GU + 3 * I_DN + j;
}
static_assert(I_EVIN <= 1 * SHADOW_PER_SEAM && I_EVIN + I_OUT <= 4 * SHADOW_PER_SEAM && I_EVIN + I_OUT + I_GU <= 5 * SHADOW_PER_SEAM && I_EVIN + I_OUT + I_GU + I_DN <= 6 * SHADOW_PER_SEAM &&
              I_EVIN + I_OUT + 2 * I_GU + I_DN <= 7 * SHADOW_PER_SEAM && I_EVIN + I_OUT + 2 * I_GU + 2 * I_DN <= 8 * SHADOW_PER_SEAM && I_EVIN + I_OUT + 2 * I_GU + 2 * I_DN + I_ODIN <= 9 * SHADOW_PER_SEAM &&
              I_EVIN + 2 * I_OUT + 2 * I_GU + 2 * I_DN + I_ODIN <= 11 * SHADOW_PER_SEAM && I_EVIN + 2 * I_OUT + 3 * I_GU + 2 * I_DN + I_ODIN <= 12 * SHADOW_PER_SEAM && SHADOW_N <= 13 * SHADOW_PER_SEAM, "shadow conversion deadlines");
__device__ __forceinline__ void p0_prologue(const Args& A, LAS unsigned char* lds, int gw, int NGW, int wave, int lane, bool deferred) {
    LAS float* scr = (LAS float*)(lds + wave * 16384);
    unsigned char* ws = A.ws;
    { const int NIT = deferred ? P0_EARLY : P0_NITEMS;
#define P0_ID(i_) (deferred ? early_item_id(i_) : (i_))
      int it = gw; P0Item d; f32x4 v[8];
      if (it < NIT) { d = p0_decode(A, P0_ID(it)); p0_load(d, v, lane); }
      while (it < NIT) { const int nit = it + NGW; P0Item dn = d; f32x4 vn[8];
#pragma unroll
          for (int i = 0; i < 8; ++i) vn[i] = v[i];
          if (nit < NIT) { dn = p0_decode(A, P0_ID(nit)); p0_load(dn, vn, lane); }
          p0_store(d, v, scr, lane); d = dn;
#pragma unroll
          for (int i = 0; i < 8; ++i) v[i] = vn[i];
          it = nit; }
#undef P0_ID
    }
    const float* x = A.in[0]; bf16* XB = (bf16*)(ws + WS_XB); float* ssp = (float*)(ws + WS_SSP);
    for (int m = gw; m < TOK; m += NGW) {
        const f32x4* xr = (const f32x4*)(x + (size_t)m * DM) + lane; f32x4 v[4]; float s = 0.f;
#pragma unroll
        for (int j = 0; j < 4; ++j) { v[j] = __builtin_nontemporal_load(xr + 64 * j); s += (v[j].x * v[j].x + v[j].y * v[j].y) + (v[j].z * v[j].z + v[j].w * v[j].w); }
        s = wave_sum(s);
        unsigned long long* o8 = (unsigned long long*)(XB + (size_t)m * DM) + lane;
#pragma unroll
        for (int j = 0; j < 4; ++j) o8[64 * j] = (unsigned long long)pk2(v[j].x, v[j].y) | ((unsigned long long)pk2(v[j].z, v[j].w) << 32);
        if (lane < 16) ssp[(size_t)m * 16 + lane] = (lane == 0) ? s : 0.f;
    }
}

__device__ __forceinline__ void forget_mfma(const Args& A, LAS unsigned char* lds, int vcu, int G, int tid, int wave, int lane) {
    typedef short bf16x8f __attribute__((ext_vector_type(8))); typedef float f32x16f __attribute__((ext_vector_type(16)));
    constexpr int WP = 1032;
    unsigned char* ws = A.ws; LAS bf16* Wt = (LAS bf16*)lds; LAS float* rsl = (LAS float*)(lds + 8 * WP * 2) + wave * 32;
    { const float* W = A.in[10]; const float* gain = A.in[5];
      for (int k = tid; k < DM; k += NWAVES * 64) { const f32x4 a = *(const f32x4*)(W + (size_t)k * 2568 + 2560), b = *(const f32x4*)(W + (size_t)k * 2568 + 2564); const float g = gain[k];
          Wt[0 * WP + k] = (bf16)(pk2(a.x * g, 0.f) & 0xffffu); Wt[1 * WP + k] = (bf16)(pk2(a.y * g, 0.f) & 0xffffu); Wt[2 * WP + k] = (bf16)(pk2(a.z * g, 0.f) & 0xffffu); Wt[3 * WP + k] = (bf16)(pk2(a.w * g, 0.f) & 0xffffu);
          Wt[4 * WP + k] = (bf16)(pk2(b.x * g, 0.f) & 0xffffu); Wt[5 * WP + k] = (bf16)(pk2(b.y * g, 0.f) & 0xffffu); Wt[6 * WP + k] = (bf16)(pk2(b.z * g, 0.f) & 0xffffu); Wt[7 * WP + k] = (bf16)(pk2(b.w * g, 0.f) & 0xffffu); } }
    __syncthreads();
    const bf16* XB = (const bf16*)(ws + WS_XB); const float* ssp = (const float*)(ws + WS_SSP); float* LF = (float*)(ws + WS_LF); const float* bfp = A.in[11];
    const int r32 = lane & 31, hi = lane >> 5;
    for (int task = wave * G + vcu; task < TOK / 32; task += G * NWAVES) {
        const int row0 = task * 32;
        if (lane < 32) { const f32x4* p = (const f32x4*)(ssp + (size_t)(row0 + lane) * 16); const f32x4 a = p[0], b = p[1], c = p[2], d = p[3];
            const float s = (((a[0] + a[1]) + (a[2] + a[3])) + ((b[0] + b[1]) + (b[2] + b[3]))) + (((c[0] + c[1]) + (c[2] + c[3])) + ((d[0] + d[1]) + (d[2] + d[3])));
            rsl[lane] = __builtin_amdgcn_rsqf(s * (1.0f / 1024.0f) + pg8::RMS_EPS); }
        f32x16f acc = f32x16f{};
        const bf16* xrow = XB + (size_t)(row0 + r32) * DM + 8 * hi; const LAS bf16* wrow = Wt + (r32 & 7) * WP + 8 * hi;
#pragma unroll 1
        for (int s0 = 0; s0 < 64; s0 += 16) { bf16x8f a[16];
#pragma unroll
            for (int j = 0; j < 16; ++j) a[j] = *(const bf16x8f*)(xrow + 16 * (s0 + j));
#pragma unroll
            for (int j = 0; j < 16; ++j) { bf16x8f b = *(const LAS bf16x8f*)(wrow + 16 * (s0 + j)); if (r32 >= 8) b = bf16x8f{};
                acc = __builtin_amdgcn_mfma_f32_32x32x16_bf16(a[j], b, acc, 0, 0, 0); } }
        LDS_WAIT();
        if (r32 < 8) { const float bb = bfp[r32];
#pragma unroll
            for (int r = 0; r < 16; ++r) { const int rr = (r & 3) + 8 * (r >> 2) + 4 * hi, row = row0 + rr; const float z = acc[r] * rsl[rr] + bb;
                LF[(size_t)((row >> 12) * 8 + r32) * SEQL + (row & (SEQL - 1))] = fminf(z, 0.f) - log1pf(__expf(-fabsf(z))); } }
        LDS_WAIT(); asm volatile("" ::: "memory");
    }
}
__device__ __forceinline__ void prep_even(const Args& A, LAS unsigned char* lds, int vcu, int G, int tid, int wave, int lane) {
    unsigned char* ws = A.ws;
    if (wave == 0 && vcu < 64) {
        const int gw = vcu; const f32x4* lf4 = (const f32x4*)((const float*)(ws + WS_LF) + (size_t)gw * SEQL) + lane * 16; f32x4 v[16];
#pragma unroll
        for (int i = 0; i < 16; ++i) v[i] = lf4[i];
        float run = 0.f;
#pragma unroll
        for (int i = 0; i < 16; ++i) { v[i].x += run; v[i].y += v[i].x; v[i].z += v[i].y; v[i].w += v[i].z; run = v[i].w; }
        float incl = run;
#pragma unroll
        for (int o = 1; o < 64; o <<= 1) { const float t = __shfl_up(incl, o); if (lane >= o) incl += t; }
        const float base = incl - run;
        f32x4* fc4 = (f32x4*)((float*)(ws + WS_FC) + (size_t)gw * SEQL) + lane * 16; v4u* f8 = (v4u*)((unsigned long long*)(ws + WS_FC8) + (size_t)gw * SEQL) + lane * 32;
#pragma unroll
        for (int i = 0; i < 16; ++i) { f32x4 bb = (v[i] + base) * (-pg8::LOG2E); fc4[i] = bb; unsigned lo_[4], hi_[4];
#pragma unroll
            for (int j = 0; j < 4; ++j) { const float x = bb[j]; const unsigned h_ = pk2(x, 0.f) & 0xffffu; const float r1 = x - __uint_as_float(h_ << 16); const unsigned d_ = pk2(r1, 0.f) & 0xffffu;
                const float r2 = r1 - __uint_as_float(d_ << 16); const unsigned l_ = pk2(r2, 0.f) & 0xffffu; lo_[j] = h_ | (d_ << 16); hi_[j] = l_ | 0x3F800000u; }
            f8[2 * i] = (v4u){lo_[0], hi_[0], lo_[1], hi_[1]}; f8[2 * i + 1] = (v4u){lo_[2], hi_[2], lo_[3], hi_[3]}; }
    }
    const bf16* VA = (const bf16*)(ws + WS_VA); bf16* CAT = (bf16*)(ws + WS_CAT);
    const float* cw = A.in[12]; const float* cb = A.in[13]; const float* cn = A.in[14];
    const int cp = tid & 255, th = tid >> 8;
    typedef float f32x2p __attribute__((ext_vector_type(2)));
    f32x2p wk[31];
#pragma unroll
    for (int k = 0; k < 31; ++k) wk[k] = *(const f32x2p*)(cw + k * 512 + 2 * cp);
    const float b0 = cb[2 * cp], b1 = cb[2 * cp + 1], g0 = cn[2 * cp], g1 = cn[2 * cp + 1];
    LAS unsigned* tile = (LAS unsigned*)lds;
    typedef float f32x2w __attribute__((ext_vector_type(2)));
    LAS f32x2w* outb = (LAS f32x2w*)(lds + 62 * 1024);
    LAS float* red = (LAS float*)(lds + 62 * 1024 + 65536);
    LAS float* rst = red + 128;
#define CONV_LOAD(tl_, buf) do { const int row0_ = (tl_) * 32, t0_ = row0_ & (SEQL - 1); _Pragma("unroll") for (int k_ = 0; k_ < 8; ++k_) { const int c_ = tid + k_ * NWAVES * 64; const int r_ = c_ >> 6, ch_ = c_ & 63; buf[k_] = (v4u){0u, 0u, 0u, 0u}; \
        if (c_ < 62 * 64 && t0_ + r_ - 30 >= 0) buf[k_] = *(const v4u*)(VA + (size_t)(row0_ + r_ - 30) * 1024 + 512 + ch_ * 8); } } while (0)
#define CONV_STORE(buf) do { _Pragma("unroll") for (int k_ = 0; k_ < 8; ++k_) { const int c_ = tid + k_ * NWAVES * 64; if (c_ < 62 * 64) *(LAS v4u*)(tile + (c_ >> 6) * 256 + (c_ & 63) * 4) = buf[k_]; } } while (0)
    v4u cur[8]; int tl = vcu; if (tl < TOK / 32) CONV_LOAD(tl, cur);
    while (tl < TOK / 32) {
        const int row0 = tl * 32;
        CONV_STORE(cur);
        __syncthreads();
        const int tn = tl + G; if (tn < TOK / 32) CONV_LOAD(tn, cur);
#pragma unroll 1
        for (int g = 0; g < 2; ++g) {
            f32x2p av[8];
#pragma unroll
            for (int j = 0; j < 8; ++j) av[j] = (f32x2p){b0, b1};
            const LAS unsigned* tp = tile + (th * 16 + g * 8) * 256 + cp;
#pragma unroll
            for (int i = 0; i < 38; ++i) { const unsigned w = tp[i * 256]; const f32x2p xv = (f32x2p){bf_lo(w), bf_hi(w)};
#pragma unroll
                for (int j = 0; j < 8; ++j) { const int k = i - j; if (k >= 0 && k < 31) av[j] = __builtin_elementwise_fma(wk[k], xv, av[j]); } }
#pragma unroll
            for (int j = 0; j < 8; ++j) { const int tt = th * 16 + g * 8 + j; outb[tt * 256 + cp] = (f32x2w){av[j].x, av[j].y};
                const float s = wave_sum(av[j].x * av[j].x + av[j].y * av[j].y); if (lane == 0) red[tt * 4 + (wave & 3)] = s; }
        }
        __syncthreads();
        if (tid < 32) { const float s = (red[tid * 4] + red[tid * 4 + 1]) + (red[tid * 4 + 2] + red[tid * 4 + 3]); rst[tid] = __builtin_amdgcn_rsqf(s * (1.0f / 512.0f) + pg8::RMS_EPS); }
        __syncthreads();
#pragma unroll 4
        for (int q = 0; q < 16; ++q) { const int tt = th * 16 + q; const float rs = rst[tt]; const f32x2w v = outb[tt * 256 + cp];
            *(unsigned*)(CAT + (size_t)(row0 + tt) * 1024 + 2 * cp) = pk2(pg8::silu_f(v.x * rs * g0), pg8::silu_f(v.y * rs * g1)); }
        __syncthreads();
        tl = tn;
    }
#undef CONV_LOAD
#undef CONV_STORE
}
__device__ __forceinline__ void conv_odd(const Args& A, int vcu, int G, int tid) {
    unsigned char* ws = A.ws;
    const bf16* __restrict__ GB = (const bf16*)(ws + WS_QK); const bf16* __restrict__ CC = (const bf16*)(ws + WS_VA); bf16* __restrict__ Y = (bf16*)(ws + WS_CAT);
    const float* w = A.in[19];
    const int sr = tid >> 7, ch = (tid & 127) * 8;
    f32x4 wa[3], wb[3];
#pragma unroll
    for (int k = 0; k < 3; ++k) { wa[k] = *(const f32x4*)(w + k * 1024 + ch); wb[k] = *(const f32x4*)(w + k * 1024 + ch + 4); }
    for (int tl = vcu; tl < TOK / 128; tl += G) {
        const int r0 = tl * 128 + sr * 32, t0 = r0 & (SEQL - 1);
        v4u c0 = (v4u){0u, 0u, 0u, 0u}, c1 = c0;
        if (t0 >= 2) c0 = *(const v4u*)(CC + (size_t)(r0 - 2) * 1024 + ch);
        if (t0 >= 1) c1 = *(const v4u*)(CC + (size_t)(r0 - 1) * 1024 + ch);
#pragma unroll 1
        for (int i = 0; i < 32; i += 4) {
            v4u cc[4], gb[4];
#pragma unroll
            for (int j = 0; j < 4; ++j) { cc[j] = *(const v4u*)(CC + (size_t)(r0 + i + j) * 1024 + ch); gb[j] = *(const v4u*)(GB + (size_t)(r0 + i + j) * 1024 + ch); }
#pragma unroll
            for (int j = 0; j < 4; ++j) { const v4u c2 = cc[j], g = gb[j]; v4u o;
#define ODD_PAIR(q, W, e0, e1) pk2(bf_lo(g.q) * (W[0][e0] * bf_lo(c0.q) + W[1][e0] * bf_lo(c1.q) + W[2][e0] * bf_lo(c2.q)), bf_hi(g.q) * (W[0][e1] * bf_hi(c0.q) + W[1][e1] * bf_hi(c1.q) + W[2][e1] * bf_hi(c2.q)))
                o.x = ODD_PAIR(x, wa, 0, 1); o.y = ODD_PAIR(y, wa, 2, 3); o.z = ODD_PAIR(z, wb, 0, 1); o.w = ODD_PAIR(w, wb, 2, 3);
#undef ODD_PAIR
                *(v4u*)(Y + (size_t)(r0 + i + j) * 1024 + ch) = o; c0 = c1; c1 = c2; }
        }
    }
}

#define XB_TMO      128
#define XB_XCNT(j)  (256  + 64 * (j))
#define XB_XSUB(j)  (1280 + 64 * (j))
#define XB_XGEN(j)  (2304 + 64 * (j))
#define XB_TOP      3328
#define XB_TOPGEN   3392
#define XCD_BAR_WORDS 3456
#define XB_SPIN_CAP (1u << 18)

__device__ __forceinline__ unsigned xb_ld(unsigned* p)              { return __hip_atomic_load(p, __ATOMIC_RELAXED, __HIP_MEMORY_SCOPE_AGENT); }
__device__ __forceinline__ unsigned xb_add(unsigned* p, unsigned v) { return __hip_atomic_fetch_add(p, v, __ATOMIC_RELAXED, __HIP_MEMORY_SCOPE_AGENT); }
__device__ __forceinline__ unsigned xb_xcc_id() { return (unsigned)__builtin_amdgcn_s_getreg((3 << 11) | 20) & 0xFu; }
#define XB_SPIN(cond, bar) do { unsigned _sp = 0; while (cond) { __builtin_amdgcn_s_sleep(1); \
    if ((++_sp & 255u) == 0u) { if (xb_ld(&(bar)[XB_TMO])) break; if (_sp > XB_SPIN_CAP) { atomicAdd(&(bar)[XB_TMO], 1u); break; } } } } while (0)

struct XcdBarrier {
    unsigned* bar; unsigned x;
    volatile LAS unsigned* st;
};

__device__ __forceinline__ XcdBarrier xcd_barrier_post(unsigned* bar, volatile LAS unsigned* st) {
    XcdBarrier b; b.bar = bar; b.x = xb_xcc_id(); b.st = st;
    if (threadIdx.x == 0) (void)xb_add(&bar[XB_XCNT(b.x)], 1u);
    return b;
}
__device__ __forceinline__ void xcd_barrier_complete(unsigned* bar, unsigned x, unsigned& nloc, unsigned& nx) {
    const unsigned G = gridDim.x * gridDim.y * gridDim.z;
    unsigned sum, cnt, mine, sp = 0u;
    for (;;) {
        sum = 0u; cnt = 0u; mine = 0u;
#pragma unroll
        for (unsigned j = 0; j < 16; ++j) { const unsigned c = xb_ld(&bar[XB_XCNT(j)]); sum += c; cnt += (c > 0u) ? 1u : 0u; mine = (j == x) ? c : mine; }
        if (sum == G) break;
        __builtin_amdgcn_s_sleep(1);
        if ((++sp & 255u) == 0u) { if (xb_ld(&bar[XB_TMO])) break; if (sp > XB_SPIN_CAP) { atomicAdd(&bar[XB_TMO], 1u); break; } }
    }
    nloc = mine > 0u ? mine : 1u; nx = cnt > 0u ? cnt : 1u;
}

__device__ __forceinline__ void xcd_barrier(const XcdBarrier& b) {
    asm volatile("s_waitcnt vmcnt(0)" ::: "memory");
    __syncthreads();
    if (threadIdx.x == 0) {
        unsigned* bar = b.bar;
        __builtin_amdgcn_s_waitcnt(0);
        unsigned nloc = b.st[0], nx = b.st[1];
        if (nloc == 0u) { xcd_barrier_complete(bar, b.x, nloc, nx); b.st[0] = nloc; b.st[1] = nx; }
        const unsigned old = xb_add(&bar[XB_XSUB(b.x)], 1u);
        const unsigned gen = old / nloc;
        if (old + 1u == (gen + 1u) * nloc) {
            __builtin_amdgcn_fence(__ATOMIC_RELEASE, "agent");
            asm volatile("s_waitcnt vmcnt(0)" ::: "memory");
            const unsigned og = xb_add(&bar[XB_TOP], 1u);
            const unsigned tg = og / nx;
            if (og + 1u == (tg + 1u) * nx) xb_add(&bar[XB_TOPGEN], 1u);
            else XB_SPIN(xb_ld(&bar[XB_TOPGEN]) == tg, bar);
            __builtin_amdgcn_fence(__ATOMIC_ACQUIRE, "agent");
            xb_add(&bar[XB_XGEN(b.x)], 1u);
            asm volatile("s_waitcnt vmcnt(0)" ::: "memory");
        } else {
            XB_SPIN(xb_ld(&bar[XB_XGEN(b.x)]) == gen, bar);
            __builtin_amdgcn_fence(__ATOMIC_ACQUIRE, "agent");
            asm volatile("s_waitcnt vmcnt(0)" ::: "memory");
        }
    }
    __syncthreads();
}

__device__ __forceinline__ void xcd_barrier_shadow(const XcdBarrier& b, const Args& A, LAS unsigned char* lds, int seam, int bx, int wave, int lane, bool on) {
    asm volatile("s_waitcnt vmcnt(0)" ::: "memory");
    __syncthreads();
    if (wave == 0) {
      if (threadIdx.x == 0) {
        unsigned* bar = b.bar;
        __builtin_amdgcn_s_waitcnt(0);
        unsigned nloc = b.st[0], nx = b.st[1];
        if (nloc == 0u) { xcd_barrier_complete(bar, b.x, nloc, nx); b.st[0] = nloc; b.st[1] = nx; }
        const unsigned old = xb_add(&bar[XB_XSUB(b.x)], 1u);
        const unsigned gen = old / nloc;
        if (old + 1u == (gen + 1u) * nloc) {
            __builtin_amdgcn_fence(__ATOMIC_RELEASE, "agent");
            asm volatile("s_waitcnt vmcnt(0)" ::: "memory");
            const unsigned og = xb_add(&bar[XB_TOP], 1u);
            const unsigned tg = og / nx;
            if (og + 1u == (tg + 1u) * nx) xb_add(&bar[XB_TOPGEN], 1u);
            else XB_SPIN(xb_ld(&bar[XB_TOPGEN]) == tg, bar);
            __builtin_amdgcn_fence(__ATOMIC_ACQUIRE, "agent");
            xb_add(&bar[XB_XGEN(b.x)], 1u);
            asm volatile("s_waitcnt vmcnt(0)" ::: "memory");
        } else {
            XB_SPIN(xb_ld(&bar[XB_XGEN(b.x)]) == gen, bar);
            __builtin_amdgcn_fence(__ATOMIC_ACQUIRE, "agent");
            asm volatile("s_waitcnt vmcnt(0)" ::: "memory");
        }
      }
    } else if (on) {
        const int j = (seam - 1) * SHADOW_PER_SEAM + bx * (NWAVES - 1) + (wave - 1);
        if (j < SHADOW_N) { const P0Item d = p0_decode(A, shadow_item_id(j)); f32x4 v[8]; p0_load(d, v, lane); p0_store(d, v, (LAS float*)(lds + wave * 16384), lane); }
    }
    __syncthreads();
}

#ifndef ATTN_V2
#define ATTN_V2 1
#endif
#if ATTN_V2
#define ATTN_CALL(b_, h_, qb_) attn_body::attn_unit<64>((b_), (h_), (qb_), (const attn_body::bf16*)QK, (const attn_body::bf16*)QK + 512, (const attn_body::bf16*)VA, (attn_body::bf16*)CAT + 512, (const attn_body::u32x4*)(ws + WS_FC8) + (size_t)((b_) * 8 + (h_)) * (SEQL / 2), js_, (char*)lds_raw)
#else
#define ATTN_CALL(b_, h_, qb_) do { (void)js_; att::attn_unit((b_), (h_), (qb_), QK, VA, CAT, FC, (char*)lds_raw); } while (0)
#endif
#ifndef MK_COOP
#define MK_COOP 1
#endif
__global__ void __launch_bounds__(NWAVES * 64, 2) trunk_fwd(Args args) {
    extern __shared__ __attribute__((aligned(16))) unsigned char lds_raw[];
    LAS unsigned char* lds = (LAS unsigned char*)lds_raw;
    cg::grid_group grid = cg::this_grid();
    const int tid = threadIdx.x, lane = tid & 63, wave = __builtin_amdgcn_readfirstlane(tid >> 6);
    const int G = gridDim.x; const int bx = blockIdx.x; const int vcu = (G % 8 == 0) ? (bx % 8) * (G / 8) + bx / 8 : bx;
    unsigned char* ws = args.ws;
    bf16* XB = (bf16*)(ws + WS_XB); bf16* HB = (bf16*)(ws + WS_H); float* ssp = (float*)(ws + WS_SSP);
    bf16* QK = (bf16*)(ws + WS_QK); bf16* VA = (bf16*)(ws + WS_VA); bf16* CAT = (bf16*)(ws + WS_CAT);
    const int lo = args.ph_lo, hi = args.ph_hi;
    volatile LAS unsigned* MISC = (volatile LAS unsigned*)(lds + MISC_OFF);
    if (tid < 32) MISC[tid] = 0u;
    __syncthreads();
    XcdBarrier bar = xcd_barrier_post((unsigned*)(ws + WS_CTL) + CW_BAR, MISC + 8);
#ifndef PH_MASK
#define PH_MASK 0xFFFF
#endif
#define IN(k) ((((PH_MASK) >> (k)) & 1) && lo <= (k) && (k) < hi)
#ifndef DUP_PHASE
#define DUP_PHASE -1
#endif
#ifndef DUP_MASK
#define DUP_MASK 0
#endif
#define REP(k) for (int rep_ = 0; rep_ < ((((DUP_MASK) >> (k)) & 1) ? 2 : 1); ++rep_)
#ifndef SYNC_EXTRA
#define SYNC_EXTRA 0
#endif
#define SEAM(k) do { if (IN(k) && IN((k) + 1)) { if ((k) == 0) grid.sync(); else xcd_barrier_shadow(bar, args, lds, (k), bx, wave, lane, deferred); for (int e_ = 0; e_ < ((k) == 1 ? SYNC_EXTRA : 0); ++e_) xcd_barrier(bar); } } while (0)
#define GEMM_GU(w) do { pg8::Gemm g{XB, (const bf16*)(ws + WS_WGU + (size_t)(w) * GU_BYTES), TOK, N_GU, DM}; pg8::StaticOrder S; S.init(TOK, N_GU, G, bx); \
        pg8::EpiSwiglu E{HB, ssp, DFF}; pg8::gemm_phase<pg8::EpiSwiglu, pg8::StaticOrder, true, true>(lds, g, S, E); } while (0)
#define GEMM_DN(w, FIN) do { pg8::Gemm g{HB, (const bf16*)(ws + WS_WDN + (size_t)(w) * DN_BYTES), TOK, DM, DFF}; pg8::StaticOrder S; S.init(TOK, DM, G, bx); \
        pg8::EpiResid<FIN> E{args.out, XB, ssp, 0.5f}; pg8::gemm_phase<pg8::EpiResid<FIN>, pg8::StaticOrder, true, true>(lds, g, S, E); } while (0)
#define GEMM_OUT(ASRC, WOFF) do { pg8::Gemm g{ASRC, (const bf16*)(ws + (WOFF)), TOK, DM, DM}; pg8::StaticOrder S; S.init(TOK, DM, G, bx); \
        pg8::EpiResid<false> E{args.out, XB, ssp, 1.0f}; pg8::gemm_phase<pg8::EpiResid<false>, pg8::StaticOrder, true, true>(lds, g, S, E); } while (0)

    const bool deferred = (G == 256) && lo == 0 && hi == N_PHASES;
    if (IN(0)) REP(0) { p0_prologue(args, lds, vcu * NWAVES + wave, G * NWAVES, wave, lane, deferred); } SEAM(0);
    if (IN(1)) { GEMM_GU(0); if ((DUP_PHASE) == 1) GEMM_GU(0); } SEAM(1);
    if (IN(2)) { GEMM_DN(0, false); } SEAM(2);
    if (IN(3)) REP(3) { pg8::Gemm g{XB, (const bf16*)(ws + WS_WEVIN), TOK, N_EVIN, DM}; pg8::StaticOrder S; S.init(TOK, N_EVIN, G, bx);
        pg8::EpiEvenIn E{QK, VA, (float*)(ws + WS_LF), ssp, args.in[15], args.in[16], args.in[11]}; pg8::gemm_phase<pg8::EpiEvenIn, pg8::StaticOrder, true, true>(lds, g, S, E);
        forget_mfma(args, lds, vcu, G, tid, wave, lane); } SEAM(3);
    if (IN(4)) REP(4) { prep_even(args, lds, vcu, G, tid, wave, lane); } SEAM(4);
    if (IN(5)) REP(5) { const float* FC = (const float*)(ws + WS_FC);
        float qkb; { float a = fabsf(args.in[15][lane]), b = fabsf(args.in[16][lane]);
#pragma unroll
            for (int o = 1; o < 64; o <<= 1) { a = fmaxf(a, __shfl_xor(a, o)); b = fmaxf(b, __shfl_xor(b, o)); }
            qkb = __uint_as_float(__builtin_amdgcn_readfirstlane(__float_as_uint(64.0f * 0.125f * pg8::LOG2E * a * b * 1.01f))); }
        unsigned* qctr = (unsigned*)(ws + WS_CTL) + CW_QUEUE; const int nq = (G >= 8) ? 8 : 1; const int myq = bx % nq;
        for (int qi = 0; qi < nq; ++qi) { const int q = (myq + qi) % nq;
          for (;;) {
            if (tid == 0) MISC[16] = atomicAdd(qctr + 64 * q, 1u);
            __syncthreads(); const int un = (int)MISC[16]; __syncthreads();
            if (un >= 1024 / nq) break;
            int bh, qb; if (nq == 8) { qb = 15 - (un >> 3); bh = q * 8 + (un & 7); } else { qb = 15 - (un >> 6); bh = un & 63; }
            int js_ = 0;
#if ATTN_V2
            { const float* fcr = FC + (size_t)bh * SEQL; const int ntile = 4 * qb + 4; const float ref = fcr[256 * qb]; int ln_ = threadIdx.x & 63; asm volatile("" : "+v"(ln_));
              const bool c = (ln_ < ntile - 4) && (ref - fcr[64 * ln_ + 63] > 2.0f * qkb + 40.0f);
              js_ = (int)__builtin_popcountll(__ballot(c)) & ~1; js_ = __builtin_amdgcn_readfirstlane(js_); }
#endif
            ATTN_CALL(bh >> 3, bh & 7, qb); } } } SEAM(5);
    if (IN(6)) GEMM_OUT(CAT, WS_WEVOUT); SEAM(6);
    if (IN(7)) GEMM_GU(1); SEAM(7);
    if (IN(8)) GEMM_DN(1, false); SEAM(8);
    if (IN(9)) GEMM_GU(2); SEAM(9);
    if (IN(10)) GEMM_DN(2, false); SEAM(10);
    if (IN(11)) REP(11) { pg8::Gemm g{XB, (const bf16*)(ws + WS_WODIN), TOK, N_ODIN, DM}; pg8::StaticOrder S; S.init(TOK, N_ODIN, G, bx);
        pg8::EpiOddIn E{VA  , QK  , ssp}; pg8::gemm_phase<pg8::EpiOddIn, pg8::StaticOrder, true, true>(lds, g, S, E); } SEAM(11);
    if (IN(12)) REP(12) { conv_odd(args, vcu, G, tid); } SEAM(12);
    if (IN(13)) GEMM_OUT(CAT  , WS_WODOUT); SEAM(13);
    if (IN(14)) GEMM_GU(3); SEAM(14);
    if (IN(15)) GEMM_DN(3, true);
#undef IN
#undef SEAM
}

extern "C" void kernel_launch(void* const* d_in, const int* in_sizes, int n_in, void* d_out, int out_size, void* d_ws, size_t ws_size, hipStream_t stream) {
    static int grid = 0;
    if (grid == 0) {
        if (n_in != 21 || in_sizes[0] != TOK * DM || out_size != TOK * DM || ws_size < WS_END) { fprintf(stderr, "kernel_launch: unexpected shapes (n_in %d, in0 %d, out %d, ws %zu); nothing launched\n", n_in, n_in > 0 ? in_sizes[0] : -1, out_size, ws_size); grid = -1; return; }
        int dev = 0, cus = 0, per_cu = 0;
        if (hipGetDevice(&dev) != hipSuccess || hipDeviceGetAttribute(&cus, hipDeviceAttributeMultiprocessorCount, dev) != hipSuccess) { grid = -1; return; }
        if (hipFuncSetAttribute((const void*)trunk_fwd, hipFuncAttributeMaxDynamicSharedMemorySize, LDS_BYTES) != hipSuccess) { fprintf(stderr, "kernel_launch: hipFuncSetAttribute failed\n"); grid = -1; return; }
        if (hipOccupancyMaxActiveBlocksPerMultiprocessor(&per_cu, (const void*)trunk_fwd, NWAVES * 64, LDS_BYTES) != hipSuccess || per_cu < 1) { fprintf(stderr, "kernel_launch: occupancy query says %d\n", per_cu); per_cu = 1; }
        (void)hipGetLastError();
        grid = cus * 1;
    }
    if (grid < 0) return;
    if (hipMemsetAsync((char*)d_ws + WS_CTL, 0, CTL_ZERO_BYTES, stream) != hipSuccess) { fprintf(stderr, "kernel_launch: memset failed\n"); return; }
    Args a{};
    for (int i = 0; i < 21; ++i) a.in[i] = (const float*)d_in[i];
    a.out = (float*)d_out; a.ws = (unsigned char*)d_ws;
#if MK_COOP
    a.ph_lo = 0; a.ph_hi = N_PHASES;
    void* kargs[] = {&a};
    hipError_t e = hipLaunchCooperativeKernel((const void*)trunk_fwd, dim3(grid), dim3(NWAVES * 64), kargs, LDS_BYTES, stream);
    if (e != hipSuccess) fprintf(stderr, "kernel_launch: cooperative launch failed: %s (grid %d)\n", hipGetErrorString(e), grid);
#else
    for (int p = 0; p < N_PHASES; ++p) { a.ph_lo = p; a.ph_hi = p + 1; hipLaunchKernelGGL(trunk_fwd, dim3(grid), dim3(NWAVES * 64), LDS_BYTES, stream, a); }
#endif
}
```

```cpp
#include <hip/hip_runtime.h>
#include <hip/hip_cooperative_groups.h>
#include <cstdio>
#include <cstdint>
#include <cmath>
namespace cg = cooperative_groups;
#define PG8_WGM 4
namespace pg8 {
#define PG8_LAS __attribute__((address_space(3)))
typedef unsigned short bf16_t;
typedef short bf16x8 __attribute__((ext_vector_type(8)));
typedef float f32x4 __attribute__((ext_vector_type(4)));
typedef unsigned u32x4 __attribute__((ext_vector_type(4)));
constexpr int BM = 256, BK = 64, HALF = 128, HTB = HALF * BK * 2  , STAGE_BYTES = 8 * HTB, NXCD = 8;
#ifndef PG8_WGM
#define PG8_WGM 8
#endif
constexpr int WGM = PG8_WGM;

__host__ __device__ __forceinline__ int lds_byte(int r, int c) { const int st = (r >> 4) * 2 + (c >> 5), rr = r & 15, cc = c & 31, ob = rr * 64 + cc * 2; return st * 1024 + (ob ^ (((ob >> 9) & 1) << 5)); }
__host__ __device__ __forceinline__ void stage_rc(int b, int& R, int& C) { const int st = b / 1024, sb = b % 1024, swz = sb ^ (((sb >> 9) & 1) << 5); R = (st >> 1) * 16 + swz / 64; C = (st & 1) * 32 + (swz % 64) / 2; }
__host__ __device__ __forceinline__ int perm32(int rho) { const int n = rho >> 4, i = rho & 15; return 8 * (i >> 2) + 4 * n + (i & 3); }

struct Unit { int pm, pn; };
struct Gemm { const bf16_t* A; const bf16_t* Bt; int M, N, K; };

struct StaticOrder {
    int nM, nN, nwg, G, c;
    __host__ __device__ void init(int M, int N, int G_, int c_) { nM = M / BM; nN = N / BM; nwg = nM * nN; G = G_; c = c_; }
    __host__ __device__ bool next(int i, Unit& u) const {
        const long L = (long)i * G + c; if (L >= nwg) return false;
        int wgid = (int)L; { const int q = nwg / NXCD, r = nwg % NXCD, xcd = wgid % NXCD, off = wgid / NXCD; wgid = (xcd < r ? xcd * (q + 1) : r * (q + 1) + (xcd - r) * q) + off; }
        const int nig = WGM * nN, gid = wgid / nig, fm = gid * WGM, gsz = (nM - fm) < WGM ? (nM - fm) : WGM;
        u.pm = fm + ((wgid % nig) % gsz); u.pn = (wgid % nig) / gsz; return true;
    }
    __device__ __forceinline__ void a_ready(const Unit&) const {}
    __device__ __forceinline__ void done(const Unit&) const {}
};

__device__ __forceinline__ unsigned cvt_pk_bf16(float lo, float hi) { unsigned r; asm volatile("v_cvt_pk_bf16_f32 %0, %1, %2" : "=v"(r) : "v"(lo), "v"(hi)); return r; }
typedef float f32x2 __attribute__((ext_vector_type(2)));
constexpr float RMS_EPS = 1e-6f;
constexpr float LOG2E = 1.4426950408889634f;
__device__ __forceinline__ float rstd_row(const float* ssp, int row, int fq) {
    const f32x4 v = *(const f32x4*)(ssp + (size_t)row * 16 + fq * 4);
    float s = (v[0] + v[1]) + (v[2] + v[3]);
    s += __shfl_xor(s, 16); s += __shfl_xor(s, 32);
    return __builtin_amdgcn_rsqf(s * (1.0f / 1024.0f) + RMS_EPS);
}
constexpr int RTAB_OFF = STAGE_BYTES + 1024, RT_MAX = 14;
template <class Sched> __device__ __forceinline__ void rtab_fill(PG8_LAS unsigned char* lds, const float* ssp, const Sched& S) {
    PG8_LAS float* rtab = (PG8_LAS float*)(lds + RTAB_OFF); Unit u; const int tid = threadIdx.x;
    for (int i = 0; i < RT_MAX && S.next(i, u); ++i) { const int r = tid >> 1, hf = tid & 1;
        const f32x4* p = (const f32x4*)(ssp + (size_t)(u.pm * BM + r) * 16 + hf * 8); const f32x4 a = p[0], b = p[1];
        float s = ((a[0] + a[1]) + (a[2] + a[3])) + ((b[0] + b[1]) + (b[2] + b[3])); s += __shfl_xor(s, 1);
        if (hf == 0) rtab[i * BM + r] = __builtin_amdgcn_rsqf(s * (1.0f / 1024.0f) + RMS_EPS); }
}
__device__ __forceinline__ void rstd_rows(const float* ssp, int row0, int fq, float (&rs)[2][4], int ui, int lrow0, PG8_LAS unsigned char* lds) {
    if (ui < RT_MAX) { const PG8_LAS float* rtab = (const PG8_LAS float*)(lds + RTAB_OFF) + ui * BM + lrow0;
#pragma unroll
        for (int ai = 0; ai < 2; ++ai)
#pragma unroll
            for (int m = 0; m < 4; ++m) rs[ai][m] = rtab[ai * HALF + m * 16];
        return; }
    f32x4 v[2][4];
#pragma unroll
    for (int ai = 0; ai < 2; ++ai)
#pragma unroll
        for (int m = 0; m < 4; ++m) v[ai][m] = *(const f32x4*)(ssp + (size_t)(row0 + ai * HALF + m * 16) * 16 + fq * 4);
#pragma unroll
    for (int ai = 0; ai < 2; ++ai)
#pragma unroll
        for (int m = 0; m < 4; ++m) { float s = (v[ai][m][0] + v[ai][m][1]) + (v[ai][m][2] + v[ai][m][3]); s += __shfl_xor(s, 16); s += __shfl_xor(s, 32); rs[ai][m] = __builtin_amdgcn_rsqf(s * (1.0f / 1024.0f) + RMS_EPS); }
}
__device__ __forceinline__ float sigmoid_f(float x) { return __builtin_amdgcn_rcpf(1.0f + __builtin_amdgcn_exp2f(-x * LOG2E)); }
__device__ __forceinline__ float silu_f(float x) { return x * sigmoid_f(x); }
__device__ __forceinline__ u32x4 pack8(const f32x4 a, const f32x4 b) { u32x4 w; w.x = cvt_pk_bf16(a[0], a[1]); w.y = cvt_pk_bf16(a[2], a[3]); w.z = cvt_pk_bf16(b[0], b[1]); w.w = cvt_pk_bf16(b[2], b[3]); return w; }

struct EpiSwiglu {
    static constexpr bool PERM = true, AFTER_DRAIN = false;
    bf16_t* H; const float* ssp; int ldh;
    template <class Sched> __device__ __forceinline__ void phase_prologue(PG8_LAS unsigned char* lds, const Sched& S) const { rtab_fill(lds, ssp, S); }
    __device__ __forceinline__ void operator()(const f32x4 (&acc)[2][2][4][2], const Unit& u, int wr, int wc, int fr, int fq, int ui, PG8_LAS unsigned char* lds) const {
        const int row0 = u.pm * BM + wr * 64 + fr, col0 = u.pn * HALF + wc * 32 + 8 * fq;
        float rsv[2][4]; rstd_rows(ssp, row0, fq, rsv, ui, wr * 64 + fr, lds);
#pragma unroll
        for (int ai = 0; ai < 2; ++ai)
#pragma unroll
            for (int m = 0; m < 4; ++m) {
                const int row = row0 + ai * HALF + m * 16; const float rs = rsv[ai][m];
                f32x4 h[2]; const float nrs = -rs * LOG2E, irr = __builtin_amdgcn_rcpf(rs * rs);
                const f32x4 irr4 = (f32x4){irr, irr, irr, irr};
#pragma unroll
                for (int n = 0; n < 2; ++n) { const f32x4 g = acc[ai][0][m][n], up = acc[ai][1][m][n]; const f32x4 t = g * nrs; f32x4 e;
#pragma unroll
                    for (int j = 0; j < 4; ++j) e[j] = __builtin_amdgcn_exp2f(t[j]);
                    const f32x4 d = __builtin_elementwise_fma(e, irr4, irr4); f32x4 r;
#pragma unroll
                    for (int j = 0; j < 4; ++j) r[j] = __builtin_amdgcn_rcpf(d[j]);
                    h[n] = (g * up) * r; }
                *(u32x4*)(H + (size_t)row * ldh + col0) = pack8(h[0], h[1]);
            }
    }
};
template <bool FINAL> struct EpiResid {
    static constexpr bool PERM = true, AFTER_DRAIN = false;
    float* xout; bf16_t* xb; float* ssp; float alpha;
    template <class Sched> __device__ __forceinline__ void phase_prologue(PG8_LAS unsigned char*, const Sched&) const {}
    __device__ __forceinline__ void operator()(const f32x4 (&acc)[2][2][4][2], const Unit& u, int wr, int wc, int fr, int fq, int ui, PG8_LAS unsigned char* lds) const {
        const int row0 = u.pm * BM + wr * 64 + fr, col0 = u.pn * BM + wc * 32 + 8 * fq;
        u32x4 xv[8][2];
#pragma unroll
        for (int it = 0; it < 8; ++it) { const size_t off = (size_t)(row0 + (it >> 2) * HALF + (it & 3) * 16) * 1024 + col0; xv[it][0] = *(const u32x4*)(xb + off); xv[it][1] = *(const u32x4*)(xb + off + HALF); }
#pragma unroll
        for (int it = 0; it < 8; ++it) {
            const int ai = it >> 2, m = it & 3;
            const int row = row0 + ai * HALF + m * 16; const size_t off = (size_t)row * 1024 + col0; f32x4 sq = (f32x4){0.f, 0.f, 0.f, 0.f};
#pragma unroll
            for (int bj = 0; bj < 2; ++bj) {
                const u32x4 xw = xv[it][bj];
                const f32x4 a0 = (f32x4){__uint_as_float(xw.x << 16), __uint_as_float(xw.x & 0xffff0000u), __uint_as_float(xw.y << 16), __uint_as_float(xw.y & 0xffff0000u)};
                const f32x4 a1 = (f32x4){__uint_as_float(xw.z << 16), __uint_as_float(xw.z & 0xffff0000u), __uint_as_float(xw.w << 16), __uint_as_float(xw.w & 0xffff0000u)};
                const f32x4 v0 = a0 + acc[ai][bj][m][0] * alpha, v1 = a1 + acc[ai][bj][m][1] * alpha;
                if constexpr (FINAL) { __builtin_nontemporal_store(v0, (f32x4*)(xout + off + bj * HALF)); __builtin_nontemporal_store(v1, (f32x4*)(xout + off + bj * HALF + 4)); }
                else {
                    *(u32x4*)(xb + off + bj * HALF) = pack8(v0, v1);
                    sq = __builtin_elementwise_fma(v0, v0, sq); sq = __builtin_elementwise_fma(v1, v1, sq); }
            }
            if constexpr (!FINAL) { float s = (sq[0] + sq[1]) + (sq[2] + sq[3]); s += __shfl_xor(s, 16); s += __shfl_xor(s, 32); if (fq == 0) ssp[(size_t)row * 16 + u.pn * 4 + wc] = s; }
        }
    }
};
struct EpiEvenIn {
    static constexpr bool PERM = true, AFTER_DRAIN = false;
    bf16_t* QK; bf16_t* VA; float* LF; const float* ssp; const float* qg; const float* kg; const float* bfp;
    template <class Sched> __device__ __forceinline__ void phase_prologue(PG8_LAS unsigned char* lds, const Sched& S) const { rtab_fill(lds, ssp, S); }
    __device__ __forceinline__ void operator()(const f32x4 (&acc)[2][2][4][2], const Unit& u, int wr, int wc, int fr, int fq, int ui, PG8_LAS unsigned char* lds) const {
        const int row0 = u.pm * BM + wr * 64 + fr; const int pn = u.pn;
        float rsv[2][4]; rstd_rows(ssp, row0, fq, rsv, ui, wr * 64 + fr, lds);
        if (pn < 4) {
            const int col0 = 512 + pn * HALF + wc * 32 + 8 * fq;
#pragma unroll
            for (int ai = 0; ai < 2; ++ai)
#pragma unroll
                for (int m = 0; m < 4; ++m) { const int row = row0 + ai * HALF + m * 16; const float rs = rsv[ai][m]; f32x4 h[2];
#pragma unroll
                    for (int n = 0; n < 2; ++n) { const f32x4 uu = acc[ai][0][m][n] * rs, g = acc[ai][1][m][n] * rs;
#pragma unroll
                        for (int j = 0; j < 4; ++j) h[n][j] = uu[j] * sigmoid_f(g[j]); }
                    *(u32x4*)(VA + (size_t)row * 1024 + col0) = pack8(h[0], h[1]); }
        } else if (pn < 8) {
            const bool isk = pn >= 6; const int head = 4 * (pn & 1) + wc; const float* gp = isk ? kg : qg; const float post = isk ? 1.0f : 0.125f * LOG2E;
            f32x4 gn[2][2];
#pragma unroll
            for (int bj = 0; bj < 2; ++bj)
#pragma unroll
                for (int n = 0; n < 2; ++n) gn[bj][n] = *(const f32x4*)(gp + 32 * bj + 8 * fq + 4 * n) * post;
            const int col0 = (isk ? 512 : 0) + head * 64 + 8 * fq;
#pragma unroll
            for (int ai = 0; ai < 2; ++ai)
#pragma unroll
                for (int m = 0; m < 4; ++m) { const int row = row0 + ai * HALF + m * 16; const float rs = rsv[ai][m]; f32x4 v[2][2]; float s = 0.f;
#pragma unroll
                    for (int bj = 0; bj < 2; ++bj)
#pragma unroll
                        for (int n = 0; n < 2; ++n) { v[bj][n] = acc[ai][bj][m][n] * rs; s += (v[bj][n][0] * v[bj][n][0] + v[bj][n][1] * v[bj][n][1]) + (v[bj][n][2] * v[bj][n][2] + v[bj][n][3] * v[bj][n][3]); }
                    s += __shfl_xor(s, 16); s += __shfl_xor(s, 32);
                    const float hr = __builtin_amdgcn_rsqf(s * (1.0f / 64.0f) + RMS_EPS);
#pragma unroll
                    for (int bj = 0; bj < 2; ++bj) *(u32x4*)(QK + (size_t)row * 1024 + col0 + 32 * bj) = pack8(v[bj][0] * hr * gn[bj][0], v[bj][1] * hr * gn[bj][1]); }
        } else if (pn < 10) {
            const int col0 = (pn - 8) * BM + wc * 32 + 8 * fq;
#pragma unroll
            for (int ai = 0; ai < 2; ++ai)
#pragma unroll
                for (int m = 0; m < 4; ++m) { const int row = row0 + ai * HALF + m * 16; const float rs = rsv[ai][m];
#pragma unroll
                    for (int bj = 0; bj < 2; ++bj) *(u32x4*)(VA + (size_t)row * 1024 + col0 + bj * HALF) = pack8(acc[ai][bj][m][0] * rs, acc[ai][bj][m][1] * rs); }
        } else {
#pragma unroll
            for (int ai = 0; ai < 2; ++ai)
#pragma unroll
                for (int m = 0; m < 4; ++m) { const int row = row0 + ai * HALF + m * 16; const float rs = rsv[ai][m];
                    if (wc == 0 && fq == 0) { const int b = row >> 12, t = row & 4095;
#pragma unroll
                        for (int n = 0; n < 2; ++n)
#pragma unroll
                            for (int j = 0; j < 4; ++j) { const int h = 4 * n + j; const float z = acc[ai][0][m][n][j] * rs + bfp[h];
                                LF[(size_t)(b * 8 + h) * 4096 + t] = fminf(z, 0.f) - log1pf(__expf(-fabsf(z))); } } }
        }
    }
};
struct EpiOddIn {
    static constexpr bool PERM = true, AFTER_DRAIN = false;
    bf16_t* CC; bf16_t* GB; const float* ssp;
    template <class Sched> __device__ __forceinline__ void phase_prologue(PG8_LAS unsigned char* lds, const Sched& S) const { rtab_fill(lds, ssp, S); }
    __device__ __forceinline__ void operator()(const f32x4 (&acc)[2][2][4][2], const Unit& u, int wr, int wc, int fr, int fq, int ui, PG8_LAS unsigned char* lds) const {
        const int row0 = u.pm * BM + wr * 64 + fr; const int pn = u.pn;
        float rsv[2][4]; rstd_rows(ssp, row0, fq, rsv, ui, wr * 64 + fr, lds);
        if (pn < 8) {
            const int col0 = pn * HALF + wc * 32 + 8 * fq;
#pragma unroll
            for (int ai = 0; ai < 2; ++ai)
#pragma unroll
                for (int m = 0; m < 4; ++m) { const int row = row0 + ai * HALF + m * 16; const float rs = rsv[ai][m]; const float rs2 = rs * rs;
                    *(u32x4*)(CC + (size_t)row * 1024 + col0) = pack8(acc[ai][0][m][0] * acc[ai][1][m][0] * rs2, acc[ai][0][m][1] * acc[ai][1][m][1] * rs2); }
        } else {
            const int col0 = (pn - 8) * BM + wc * 32 + 8 * fq;
#pragma unroll
            for (int ai = 0; ai < 2; ++ai)
#pragma unroll
                for (int m = 0; m < 4; ++m) { const int row = row0 + ai * HALF + m * 16; const float rs = rsv[ai][m];
#pragma unroll
                    for (int bj = 0; bj < 2; ++bj) *(u32x4*)(GB + (size_t)row * 1024 + col0 + bj * HALF) = pack8(acc[ai][bj][m][0] * rs, acc[ai][bj][m][1] * rs); }
        }
    }
};
template <class Epi, class Sched, bool ALIGN_EPI = false, bool SP2 = false>
__device__ __forceinline__ void gemm_phase(PG8_LAS unsigned char* lds, const Gemm g, const Sched& S, const Epi& E) {
    const int tid = threadIdx.x, wid = __builtin_amdgcn_readfirstlane(tid >> 6), lane = tid & 63, wr = wid >> 2, wc = wid & 3, fr = lane & 15, fq = lane >> 4;
    const int K = g.K, nt = K / BK;
    unsigned voffA[2], voffB[2];
#pragma unroll
    for (int i = 0; i < 2; ++i) { int R, C; stage_rc(tid * 16 + i * 8192, R, C); const int Rb = Epi::PERM ? ((R & ~31) + perm32(R & 31)) : R;
        voffA[i] = (unsigned)(R * K + C) * 2u; voffB[i] = (unsigned)(Rb * K + C) * 2u; }
    const size_t kstep = (size_t)(BK * 2);
    const size_t hstep = (size_t)HALF * K * 2;
    const size_t tstep = 2 * hstep;
    const unsigned ldsw = (unsigned)wid * 1024u;
    const int aoff = lds_byte(wr * 64 + fr, fq * 8), boff = lds_byte(wc * 32 + fr, fq * 8);
#define PG8_SA(b, h) (((b) * 2 + (h)) * HTB)
#define PG8_SB(b, h) ((4 + (b) * 2 + (h)) * HTB)
#define PG8_STAGE(bufoff, gbase, voff) do { _Pragma("unroll") for (int _i = 0; _i < 2; ++_i) \
        __builtin_amdgcn_global_load_lds((const unsigned*)((const char*)(gbase) + (voff)[_i]), (PG8_LAS unsigned*)(lds + (bufoff) + ldsw + _i * 8192), 16, 0, 0); } while (0)
#define PG8_LDA(dst, b, h) do { _Pragma("unroll") for (int m = 0; m < 4; ++m) _Pragma("unroll") for (int k = 0; k < 2; ++k) dst[m][k] = *(const PG8_LAS bf16x8*)(lds + PG8_SA(b, h) + aoff + m * 2048 + k * 1024); } while (0)
#define PG8_LDB(dst, b, h) do { _Pragma("unroll") for (int n = 0; n < 2; ++n) _Pragma("unroll") for (int k = 0; k < 2; ++k) dst[n][k] = *(const PG8_LAS bf16x8*)(lds + PG8_SB(b, h) + boff + n * 2048 + k * 1024); } while (0)
#define PG8_MMA(ai, bj, At, Bt) do { __builtin_amdgcn_s_setprio(1); _Pragma("unroll") for (int m = 0; m < 4; ++m) _Pragma("unroll") for (int n = 0; n < 2; ++n) _Pragma("unroll") for (int k = 0; k < 2; ++k) \
        acc[ai][bj][m][n] = __builtin_amdgcn_mfma_f32_16x16x32_bf16(Bt[n][k], At[m][k], acc[ai][bj][m][n], 0, 0, 0); __builtin_amdgcn_s_setprio(0); } while (0)
#define PG8_WAIT_V(n) asm volatile("s_waitcnt vmcnt(" #n ")" ::: "memory")
#define PG8_WAIT_L(n) asm volatile("s_waitcnt lgkmcnt(" #n ")" ::: "memory")
#define PG8_BAR __builtin_amdgcn_s_barrier()
#define PG8_SCHED __builtin_amdgcn_sched_barrier(0)
    Unit cur, nxt; int ui = 0;
    if (!S.next(0, cur)) return;
    f32x4 acc[2][2][4][2];
#pragma unroll
    for (int a = 0; a < 2; ++a)
#pragma unroll
        for (int b = 0; b < 2; ++b)
#pragma unroll
            for (int m = 0; m < 4; ++m)
#pragma unroll
                for (int n = 0; n < 2; ++n) acc[a][b][m][n] = (f32x4){0.f, 0.f, 0.f, 0.f};
    bf16x8 At[4][2], B0[2][2], B1[2][2];
    const char* cA = (const char*)g.A + (size_t)cur.pm * tstep; const char* cB = (const char*)g.Bt + (size_t)cur.pn * tstep;
    S.a_ready(cur);
    if constexpr (SP2) {
        PG8_STAGE(PG8_SB(0, 0), cB, voffB); PG8_STAGE(PG8_SB(0, 1), cB + hstep, voffB); PG8_STAGE(PG8_SA(0, 0), cA, voffA); PG8_STAGE(PG8_SA(0, 1), cA + hstep, voffA);
        E.phase_prologue(lds, S);
        if (wr == 1) PG8_BAR;
        PG8_WAIT_V(2); PG8_BAR;
        PG8_STAGE(PG8_SB(1, 0), cB + kstep, voffB); PG8_STAGE(PG8_SA(1, 0), cA + kstep, voffA); PG8_STAGE(PG8_SB(1, 1), cB + hstep + kstep, voffB);
        PG8_WAIT_V(6); PG8_BAR;
    } else {
        PG8_STAGE(PG8_SB(0, 0), cB, voffB); PG8_STAGE(PG8_SA(0, 0), cA, voffA); PG8_STAGE(PG8_SB(0, 1), cB + hstep, voffB); PG8_STAGE(PG8_SA(0, 1), cA + hstep, voffA);
        if (wr == 1) PG8_BAR;
        PG8_WAIT_V(4); PG8_BAR;
        PG8_STAGE(PG8_SB(1, 0), cB + kstep, voffB); PG8_STAGE(PG8_SA(1, 0), cA + kstep, voffA); PG8_STAGE(PG8_SB(1, 1), cB + hstep + kstep, voffB);
        PG8_WAIT_V(6); PG8_BAR;
    }
    for (;;) {
        const bool has_next = S.next(ui + 1, nxt);
        const char* nA = has_next ? (const char*)g.A + (size_t)nxt.pm * tstep : cA; const char* nB = has_next ? (const char*)g.Bt + (size_t)nxt.pn * tstep : cB;
        asm volatile(".p2align 8" ::: "memory");
        for (int t = 0; t < nt; t += 2) {
            const bool last = (t == nt - 2);
            const char* a1 = cA + (size_t)(t + 1) * kstep;
            const char* a2 = last ? nA : cA + (size_t)(t + 2) * kstep; const char* b2 = last ? nB : cB + (size_t)(t + 2) * kstep;
            const char* a3 = a2 + kstep; const char* b3 = b2 + kstep;
            if (last && has_next) S.a_ready(nxt);
            if constexpr (SP2) {
            PG8_LDB(B0, 0, 0); PG8_LDB(B1, 0, 1); PG8_SCHED; PG8_LDA(At, 0, 0); PG8_STAGE(PG8_SA(1, 1), a1 + hstep, voffA);
            PG8_WAIT_V(8); PG8_WAIT_L(0); PG8_BAR; PG8_MMA(0, 0, At, B0); PG8_MMA(0, 1, At, B1); PG8_BAR; PG8_SCHED;
            PG8_LDA(At, 0, 1); PG8_STAGE(PG8_SB(0, 0), b2, voffB); PG8_STAGE(PG8_SB(0, 1), b2 + hstep, voffB); PG8_STAGE(PG8_SA(0, 0), a2, voffA);
            PG8_WAIT_V(8); PG8_WAIT_L(0); PG8_BAR; PG8_MMA(1, 0, At, B0); PG8_MMA(1, 1, At, B1); PG8_BAR; PG8_SCHED;
            PG8_LDB(B0, 1, 0); PG8_LDB(B1, 1, 1); PG8_SCHED; PG8_LDA(At, 1, 0); PG8_STAGE(PG8_SA(0, 1), a2 + hstep, voffA);
            PG8_WAIT_V(8); PG8_WAIT_L(0); PG8_BAR; PG8_MMA(0, 0, At, B0); PG8_MMA(0, 1, At, B1); PG8_BAR; PG8_SCHED;
            PG8_LDA(At, 1, 1); PG8_STAGE(PG8_SB(1, 0), b3, voffB); PG8_STAGE(PG8_SB(1, 1), b3 + hstep, voffB); PG8_STAGE(PG8_SA(1, 0), a3, voffA);
            PG8_WAIT_V(8); PG8_WAIT_L(0); PG8_BAR; PG8_MMA(1, 0, At, B0); PG8_MMA(1, 1, At, B1); PG8_BAR; PG8_SCHED;
            } else {
            PG8_LDB(B0, 0, 0); PG8_SCHED; PG8_LDA(At, 0, 0); PG8_STAGE(PG8_SA(1, 1), a1 + hstep, voffA);
            PG8_WAIT_L(8); PG8_BAR; PG8_WAIT_L(0); PG8_MMA(0, 0, At, B0); PG8_BAR; PG8_SCHED;
            PG8_LDB(B1, 0, 1); PG8_STAGE(PG8_SB(0, 0), b2, voffB);
            PG8_BAR; PG8_WAIT_L(0); PG8_MMA(0, 1, At, B1); PG8_BAR;
            PG8_LDA(At, 0, 1); PG8_STAGE(PG8_SA(0, 0), a2, voffA);
            PG8_BAR; PG8_WAIT_L(0); PG8_MMA(1, 0, At, B0); PG8_BAR; PG8_SCHED;
            PG8_STAGE(PG8_SB(0, 1), b2 + hstep, voffB);
            PG8_WAIT_V(6); PG8_BAR; PG8_MMA(1, 1, At, B1); PG8_BAR;
            PG8_LDB(B0, 1, 0); PG8_SCHED; PG8_LDA(At, 1, 0); PG8_STAGE(PG8_SA(0, 1), a2 + hstep, voffA);
            PG8_WAIT_L(8); PG8_BAR; PG8_WAIT_L(0); PG8_MMA(0, 0, At, B0); PG8_BAR; PG8_SCHED;
            PG8_LDB(B1, 1, 1); PG8_STAGE(PG8_SB(1, 0), b3, voffB);
            PG8_BAR; PG8_WAIT_L(0); PG8_MMA(0, 1, At, B1); PG8_BAR;
            PG8_LDA(At, 1, 1); PG8_STAGE(PG8_SA(1, 0), a3, voffA);
            PG8_BAR; PG8_WAIT_L(0); PG8_MMA(1, 0, At, B0); PG8_BAR; PG8_SCHED;
            PG8_STAGE(PG8_SB(1, 1), b3 + hstep, voffB);
            PG8_WAIT_V(6); PG8_BAR; PG8_MMA(1, 1, At, B1); PG8_BAR;
            }
        }
        if constexpr (ALIGN_EPI) { if (wr == 0) PG8_BAR; }
        if constexpr (!Epi::AFTER_DRAIN) { E(acc, cur, wr, wc, fr, fq, ui, lds); S.done(cur); }
        if (!has_next) break;
#pragma unroll
        for (int a = 0; a < 2; ++a)
#pragma unroll
            for (int b = 0; b < 2; ++b)
#pragma unroll
                for (int m = 0; m < 4; ++m)
#pragma unroll
                    for (int n = 0; n < 2; ++n) acc[a][b][m][n] = (f32x4){0.f, 0.f, 0.f, 0.f};
        cur = nxt; cA = nA; cB = nB; ++ui;
        if constexpr (ALIGN_EPI) { if (wr == 1) PG8_BAR; }
    }
    PG8_WAIT_V(0);
    if constexpr (!ALIGN_EPI) { if (wr == 0) PG8_BAR; }
    PG8_BAR;
    if constexpr (Epi::AFTER_DRAIN) { E.fused(acc, cur, wr, wc, fr, fq, lds, wid, lane); S.done(cur); }
#undef PG8_SA
#undef PG8_SB
#undef PG8_STAGE
#undef PG8_LDA
#undef PG8_LDB
#undef PG8_MMA
#undef PG8_WAIT_V
#undef PG8_WAIT_L
#undef PG8_BAR
#undef PG8_SCHED
}
}
namespace att {
typedef short bf16x8 __attribute__((ext_vector_type(8)));
typedef short s16x4 __attribute__((ext_vector_type(4)));
typedef float f32x16 __attribute__((ext_vector_type(16)));
typedef float f32x4 __attribute__((ext_vector_type(4)));
typedef unsigned u32x4 __attribute__((ext_vector_type(4)));
typedef unsigned short bf16_t;
constexpr int SEQ = 4096, PITCH = 1024, QB = 256, KVBLK = 64, NW = 8, SLOTB = 8192;
constexpr int NSLOT = 4; constexpr int L_K = 0, L_V = NSLOT * SLOTB, L_BIAS = 2 * NSLOT * SLOTB, L_WS = L_BIAS + SEQ * 4, L_OST = L_WS + NW * 64 * 4, L_BYTES = L_OST + NW * 4096;
__device__ __forceinline__ int crow(int r, int hi) { return (r & 3) + 8 * (r >> 2) + 4 * hi; }
__device__ __forceinline__ void glds16(const void* gsrc, unsigned lds_dst) { unsigned keep;
    asm volatile("s_mov_b32 %0, m0\n\ts_mov_b32 m0, %2\n\ts_nop 0\n\tglobal_load_lds_dwordx4 %1, off\n\ts_mov_b32 m0, %0" : "=&s"(keep) : "v"(gsrc), "s"(lds_dst) : "memory"); }
typedef float f32x2_t __attribute__((ext_vector_type(2))); typedef __bf16 bf16x2_t __attribute__((ext_vector_type(2)));
__device__ __forceinline__ unsigned cvtpk_s(float lo, float hi) { f32x2_t v = {lo, hi}; bf16x2_t b = __builtin_convertvector(v, bf16x2_t); return __builtin_bit_cast(unsigned, b); }
#define ATT_WAIT_BAR() asm volatile("s_waitcnt vmcnt(0) lgkmcnt(0)\n\ts_barrier" ::: "memory")
__device__ __forceinline__ void pv(f32x16* o, int vb, bf16x8 pa0, bf16x8 pa1, bf16x8 pa2, bf16x8 pa3) {
#pragma unroll
    for (int d0 = 0; d0 < 2; ++d0) { s16x4 lo[4], hi[4];
#pragma unroll
        for (int ks = 0; ks < 4; ++ks) {
            asm volatile("ds_read_b64_tr_b16 %0,%1 offset:%c2" : "=&v"(lo[ks]) : "v"(vb), "i"(d0 * 4096 + ks * 1024) : "memory");
            asm volatile("ds_read_b64_tr_b16 %0,%1 offset:%c2" : "=&v"(hi[ks]) : "v"(vb), "i"(d0 * 4096 + ks * 1024 + 512) : "memory"); }
        asm volatile("s_waitcnt lgkmcnt(0)" ::: "memory"); __builtin_amdgcn_sched_barrier(0);
#define ATT_PK(k) (bf16x8){lo[k][0], lo[k][1], lo[k][2], lo[k][3], hi[k][0], hi[k][1], hi[k][2], hi[k][3]}
        o[d0] = __builtin_amdgcn_mfma_f32_32x32x16_bf16(pa0, ATT_PK(0), o[d0], 0, 0, 0);
        o[d0] = __builtin_amdgcn_mfma_f32_32x32x16_bf16(pa1, ATT_PK(1), o[d0], 0, 0, 0);
        o[d0] = __builtin_amdgcn_mfma_f32_32x32x16_bf16(pa2, ATT_PK(2), o[d0], 0, 0, 0);
        o[d0] = __builtin_amdgcn_mfma_f32_32x32x16_bf16(pa3, ATT_PK(3), o[d0], 0, 0, 0);
#undef ATT_PK
    }
}
typedef __attribute__((address_space(3))) const char* lds_cptr;
typedef __attribute__((address_space(3))) float* lds_fptr;
__device__ __forceinline__ void attn_unit(int b, int h, int qb, const bf16_t* QKb, const bf16_t* VAb, bf16_t* CAT, const float* FC, char* shm) {
    const int tid = threadIdx.x, lane = tid & 63, r32 = lane & 31, hi = lane >> 5; const int wid = __builtin_amdgcn_readfirstlane(tid >> 6);
    const long rowbase = (long)b * SEQ; const int q0 = qb * QB;
    const bf16_t* Qw = QKb + (rowbase + q0 + wid * 32) * PITCH + h * 64;
    const bf16_t* Kh = QKb + rowbase * PITCH + 512 + h * 64; const bf16_t* Vh = VAb + rowbase * PITCH + h * 64;
    const unsigned lds0 = (unsigned)(uintptr_t)shm;
    const lds_cptr shm3 = (lds_cptr)shm;
    lds_fptr wsf = (lds_fptr)(shm3 + L_WS) + wid * 64;
    lds_fptr bt = (lds_fptr)(shm3 + L_BIAS);
    const bf16_t* ksrc = Kh + (long)lane * PITCH + wid * 8;
    const bf16_t* vsrc = Vh + (long)(16 * (wid & 3) + (lane >> 2)) * PITCH + (wid >> 2) * 32 + (lane & 3) * 8;
    const unsigned kdst = lds0 + L_K + wid * 1024, vdst = lds0 + L_V + wid * 1024;
#define ATT_DMA_K(t, slot) glds16(ksrc + (long)(t) * KVBLK * PITCH, (unsigned)__builtin_amdgcn_readfirstlane(kdst + (slot)))
#define ATT_DMA_V(t, slot) glds16(vsrc + (long)(t) * KVBLK * PITCH, (unsigned)__builtin_amdgcn_readfirstlane(vdst + (slot)))
    const int vb0 = (int)(lds0 + L_V) + ((lane >> 4) & 1) * 32 + (lane & 3) * 8 + (4 * hi + ((lane & 15) >> 2)) * 64;
    const lds_cptr kp0 = shm3 + L_K + hi * 1024 + r32 * 16;
    const int NT = (q0 + QB) / KVBLK;
    { const float* fcr = FC + (size_t)(b * 8 + h) * SEQ;
      for (int i = tid; i < (q0 + QB) / 4; i += NW * 64) *((__attribute__((address_space(3))) f32x4*)bt + i) = *((const f32x4*)fcr + i); }
    ATT_DMA_K(0, 0); ATT_DMA_V(0, 0); ATT_DMA_K(1, SLOTB); ATT_DMA_V(1, SLOTB); ATT_DMA_K(2, 2 * SLOTB); ATT_DMA_V(2, 2 * SLOTB);
    bf16x8 qr[4];
#pragma unroll
    for (int d0 = 0; d0 < 4; ++d0) qr[d0] = *reinterpret_cast<const bf16x8*>(&Qw[(long)r32 * PITCH + d0 * 16 + hi * 8]);
    float mrun = -INFINITY, l_reg = 0.f; f32x16 o[2]; o[0] = f32x16{}; o[1] = f32x16{};
    const int qabs = q0 + wid * 32 + r32;
    asm volatile("s_waitcnt vmcnt(4) lgkmcnt(0)\n\ts_barrier" ::: "memory");
    for (int t = 0; t < NT; ++t) {
        const int slot = (t & 3) * SLOTB;
        if (t + 3 < NT) { const int ns = ((t + 3) & 3) * SLOTB; ATT_DMA_K(t + 3, ns); ATT_DMA_V(t + 3, ns); }
        if (64 * t <= q0 + wid * 32 + 31) {
            f32x16 p0, p1;
            { const lds_fptr bp = bt + 64 * t + 4 * hi;
#pragma unroll
              for (int g = 0; g < 4; ++g) { const f32x4 a = *(const __attribute__((address_space(3))) f32x4*)(bp + 8 * g), c = *(const __attribute__((address_space(3))) f32x4*)(bp + 32 + 8 * g);
#pragma unroll
                  for (int j = 0; j < 4; ++j) { p0[4 * g + j] = a[j]; p1[4 * g + j] = c[j]; } } }
            const lds_cptr kp = kp0 + slot;
#pragma unroll
            for (int d0 = 0; d0 < 4; ++d0) {
                const bf16x8 b0 = *(const __attribute__((address_space(3))) bf16x8*)(kp + d0 * 2048);
                const bf16x8 b1 = *(const __attribute__((address_space(3))) bf16x8*)(kp + d0 * 2048 + 512);
                p0 = __builtin_amdgcn_mfma_f32_32x32x16_bf16(b0, qr[d0], p0, 0, 0, 0);
                p1 = __builtin_amdgcn_mfma_f32_32x32x16_bf16(b1, qr[d0], p1, 0, 0, 0);
            }
            if (64 * t + 63 > q0 + wid * 32) {
#pragma unroll
                for (int r = 0; r < 16; ++r) { const int kv = 64 * t + crow(r, hi); if (kv > qabs) p0[r] = -INFINITY; if (kv + 32 > qabs) p1[r] = -INFINITY; }
            }
            float rm = p0[0];
#pragma unroll
            for (int r = 1; r < 16; ++r) rm = fmaxf(rm, p0[r]);
#pragma unroll
            for (int r = 0; r < 16; ++r) rm = fmaxf(rm, p1[r]);
            rm = fmaxf(rm, __shfl_xor(rm, 32));
            const float mnew = fmaxf(mrun, rm); const float alpha = __builtin_amdgcn_exp2f(mrun - mnew); mrun = mnew;
            float ls = 0.f;
#pragma unroll
            for (int r = 0; r < 16; ++r) { p0[r] = __builtin_amdgcn_exp2f(p0[r] - mnew); p1[r] = __builtin_amdgcn_exp2f(p1[r] - mnew); ls += p0[r] + p1[r]; }
            l_reg = l_reg * alpha + ls;
            if (hi == 0) wsf[r32] = alpha;
            asm volatile("s_waitcnt lgkmcnt(0)" ::: "memory");
#pragma unroll
            for (int r = 0; r < 16; ++r) { const float f = wsf[crow(r, hi)]; o[0][r] *= f; o[1][r] *= f; }
            u32x4 pw0 = (u32x4){cvtpk_s(p0[0], p0[1]), cvtpk_s(p0[2], p0[3]), cvtpk_s(p0[4], p0[5]), cvtpk_s(p0[6], p0[7])};
            u32x4 pw1 = (u32x4){cvtpk_s(p0[8], p0[9]), cvtpk_s(p0[10], p0[11]), cvtpk_s(p0[12], p0[13]), cvtpk_s(p0[14], p0[15])};
            u32x4 pw2 = (u32x4){cvtpk_s(p1[0], p1[1]), cvtpk_s(p1[2], p1[3]), cvtpk_s(p1[4], p1[5]), cvtpk_s(p1[6], p1[7])};
            u32x4 pw3 = (u32x4){cvtpk_s(p1[8], p1[9]), cvtpk_s(p1[10], p1[11]), cvtpk_s(p1[12], p1[13]), cvtpk_s(p1[14], p1[15])};
            asm volatile("s_waitcnt lgkmcnt(0)" ::: "memory");
            pv(o, vb0 + slot, __builtin_bit_cast(bf16x8, pw0), __builtin_bit_cast(bf16x8, pw1), __builtin_bit_cast(bf16x8, pw2), __builtin_bit_cast(bf16x8, pw3));
        }
        if (t + 3 < NT) asm volatile("s_waitcnt vmcnt(4) lgkmcnt(0)\n\ts_barrier" ::: "memory");
        else if (t + 2 < NT) asm volatile("s_waitcnt vmcnt(2) lgkmcnt(0)\n\ts_barrier" ::: "memory");
        else ATT_WAIT_BAR();
    }
    l_reg += __shfl_xor(l_reg, 32);
    if (hi == 0) wsf[32 + r32] = l_reg;
    asm volatile("s_waitcnt lgkmcnt(0)" ::: "memory");
    float rli[16];
#pragma unroll
    for (int r = 0; r < 16; ++r) rli[r] = __builtin_amdgcn_rcpf(wsf[32 + crow(r, hi)]);
    bf16_t* Ow = CAT + (rowbase + q0 + wid * 32) * PITCH + 512 + h * 64;
    { __attribute__((address_space(3))) bf16_t* stg = (__attribute__((address_space(3))) bf16_t*)(shm3 + L_OST) + wid * 2048;
#pragma unroll
      for (int r = 0; r < 16; ++r) { const int orow = crow(r, hi);
#pragma unroll
          for (int d0 = 0; d0 < 2; ++d0) stg[orow * 64 + d0 * 32 + r32] = (bf16_t)(cvtpk_s(o[d0][r] * rli[r], 0.f) & 0xffffu); }
      asm volatile("s_waitcnt lgkmcnt(0)" ::: "memory");
#pragma unroll
      for (int i = 0; i < 4; ++i) { const int row = i * 8 + (lane >> 3), ch = lane & 7; const u32x4 v = *(const __attribute__((address_space(3))) u32x4*)(stg + row * 64 + ch * 8); *(u32x4*)(Ow + (long)row * PITCH + ch * 8) = v; } }
    asm volatile("s_waitcnt lgkmcnt(0)\n\ts_barrier" ::: "memory");
#undef ATT_DMA_K
#undef ATT_DMA_V
}
#undef ATT_WAIT_BAR
}
#include <hip/hip_bf16.h>
#include <cmath>
namespace attn_body {
using bf16=__hip_bfloat16;
using bf16x8=__attribute__((ext_vector_type(8)))short;
using s16x4=__attribute__((ext_vector_type(4)))short;
using f32x16=__attribute__((ext_vector_type(16)))float;
using u32x4=__attribute__((ext_vector_type(4)))unsigned;
using u32x2=__attribute__((ext_vector_type(2)))unsigned;
constexpr int BATCH=8,SEQ=4096,D=64,DM=1024;
constexpr int NW=8,QBLK=32,QB=QBLK*NW,KVBLK=64,NQB=SEQ/QB;
constexpr int ATTN_PITCH=DM, ATTN_UNIT_ROWS=QB;
__device__ __forceinline__ int crow(int r,int hi){return (r&3)+8*(r>>2)+4*hi;}
#define SBAR() __builtin_amdgcn_sched_barrier(0)
__device__ __forceinline__ void cmask(f32x16&p0,f32x16&p1,int jb,int qrel,int hi){
  asm volatile("":"+v"(hi));
  const float NEG=-INFINITY; int kb=64*jb+4*hi;
  #pragma unroll
  for(int r=0;r<16;++r){int kv=kb+(r&3)+8*(r>>2); if(kv>qrel)p0[r]=NEG; if(kv+32>qrel)p1[r]=NEG;}
}

constexpr int NSLOT=3, SLOTB=8192;
constexpr int LDS_K=0, LDS_V=NSLOT*SLOTB, LDS_WS=2*NSLOT*SLOTB, LDS_OST=LDS_WS+NW*64*4, LDS_BIAS=LDS_OST+NW*4096, LDS_BYTES=LDS_BIAS+SEQ*8;
constexpr float C2=0.125f*1.4426950408889634f;
__device__ __forceinline__ void glds16(const void*gsrc,unsigned lds_dst){unsigned keep;
  asm volatile("s_mov_b32 %0, m0\n\ts_mov_b32 m0, %2\n\ts_nop 0\n\tglobal_load_lds_dwordx4 %1, off\n\ts_mov_b32 m0, %0":"=&s"(keep):"v"(gsrc),"s"(lds_dst):"memory");}
__device__ __forceinline__ float max3f(float a,float b,float c){float r;asm("v_max3_f32 %0, %1, %2, %3":"=v"(r):"v"(a),"v"(b),"v"(c));return r;}
__device__ __forceinline__ float max2f(float a,float b){float r;asm("v_max_f32_e32 %0, %1, %2":"=v"(r):"v"(a),"v"(b));return r;}
__device__ __forceinline__ float fadd_s(float a,float b){float r;asm("v_add_f32_e32 %0, %1, %2":"=v"(r):"v"(a),"v"(b));return r;}
__device__ __forceinline__ float fsub_s(float a,float b){float r;asm("v_sub_f32_e32 %0, %1, %2":"=v"(r):"v"(a),"v"(b));return r;}
typedef float f32x2_t __attribute__((ext_vector_type(2))); typedef __bf16 bf16x2_t __attribute__((ext_vector_type(2)));
__device__ __forceinline__ unsigned cvtpk_s(float lo,float hi){f32x2_t v={lo,hi};bf16x2_t b=__builtin_convertvector(v,bf16x2_t);return __builtin_bit_cast(unsigned,b);}
#define WAIT_BAR(N) asm volatile("s_waitcnt vmcnt(" #N ") lgkmcnt(0)\n\ts_barrier":::"memory")

__device__ __forceinline__ void qkt(f32x16&p0,f32x16&p1,const char*Kslot,const bf16x8*qr,int r32,int hi){
  const char*kb=Kslot+hi*1024+r32*16;
  #pragma unroll
  for(int d0=0;d0<4;++d0){
    const bf16x8 b0=*reinterpret_cast<const bf16x8*>(kb+d0*2048);
    const bf16x8 b1=*reinterpret_cast<const bf16x8*>(kb+d0*2048+512);
    {p0=__builtin_amdgcn_mfma_f32_32x32x16_bf16(b0,qr[d0],p0,0,0,0);p1=__builtin_amdgcn_mfma_f32_32x32x16_bf16(b1,qr[d0],p1,0,0,0);}}
}
typedef __attribute__((address_space(3))) const char* lds_cptr;
typedef short v4i16_t __attribute__((ext_vector_type(4)));
__device__ __forceinline__ void kload8(bf16x8*kf,lds_cptr kp){
  kf[0]=*(const __attribute__((address_space(3))) bf16x8*)(kp);      kf[1]=*(const __attribute__((address_space(3))) bf16x8*)(kp+512);
  kf[2]=*(const __attribute__((address_space(3))) bf16x8*)(kp+2048); kf[3]=*(const __attribute__((address_space(3))) bf16x8*)(kp+2560);
  kf[4]=*(const __attribute__((address_space(3))) bf16x8*)(kp+4096); kf[5]=*(const __attribute__((address_space(3))) bf16x8*)(kp+4608);
  kf[6]=*(const __attribute__((address_space(3))) bf16x8*)(kp+6144); kf[7]=*(const __attribute__((address_space(3))) bf16x8*)(kp+6656);
}
__device__ __forceinline__ void kload2(bf16x8*kf,lds_cptr kp,int j){ kf[2*j]=*(const __attribute__((address_space(3))) bf16x8*)(kp+j*2048); kf[2*j+1]=*(const __attribute__((address_space(3))) bf16x8*)(kp+j*2048+512); }
__device__ __forceinline__ s16x4 vtr(lds_cptr p){ return __builtin_bit_cast(s16x4,__builtin_amdgcn_ds_read_tr16_b64_v4i16((__attribute__((address_space(3))) v4i16_t*)p)); }
__device__ __forceinline__ float rowmax(const f32x16&p0,const f32x16&p1){
  float a=max3f(p0[0],p0[1],p1[0]),b=max3f(p0[2],p0[3],p1[1]);a=max3f(a,p1[2],p1[3]);
  #pragma unroll
  for(int r=4;r<16;r+=4){a=max3f(a,p0[r],p0[r+1]);b=max3f(b,p0[r+2],p0[r+3]);a=max3f(a,p1[r],p1[r+1]);b=max3f(b,p1[r+2],p1[r+3]);}
  const float m=max2f(a,b);
  auto rr=__builtin_amdgcn_permlane32_swap(__float_as_uint(m),__float_as_uint(m),false,false);
  return max2f(__uint_as_float(rr[0]),__uint_as_float(rr[1]));
}
__device__ __forceinline__ void pv(f32x16*o,int vb,bf16x8 pa0,bf16x8 pa1,bf16x8 pa2,bf16x8 pa3){
  #pragma unroll
  for(int d0=0;d0<2;++d0){s16x4 lo[4],hi[4];
    #pragma unroll
    for(int ks=0;ks<4;++ks){
      asm volatile("ds_read_b64_tr_b16 %0,%1 offset:%c2":"=&v"(lo[ks]):"v"(vb),"i"(d0*4096+ks*1024):"memory");
      asm volatile("ds_read_b64_tr_b16 %0,%1 offset:%c2":"=&v"(hi[ks]):"v"(vb),"i"(d0*4096+ks*1024+512):"memory");}
    asm volatile("s_waitcnt lgkmcnt(0)":::"memory");SBAR();
    #define PK(k) (bf16x8){lo[k][0],lo[k][1],lo[k][2],lo[k][3],hi[k][0],hi[k][1],hi[k][2],hi[k][3]}
    o[d0]=__builtin_amdgcn_mfma_f32_32x32x16_bf16(pa0,PK(0),o[d0],0,0,0);
    o[d0]=__builtin_amdgcn_mfma_f32_32x32x16_bf16(pa1,PK(1),o[d0],0,0,0);
    o[d0]=__builtin_amdgcn_mfma_f32_32x32x16_bf16(pa2,PK(2),o[d0],0,0,0);
    o[d0]=__builtin_amdgcn_mfma_f32_32x32x16_bf16(pa3,PK(3),o[d0],0,0,0);
    #undef PK
  }
}

#ifndef ATTN_STORE16
#define ATTN_STORE16(p,v) (*(u32x4*)(p)=(v))
#endif
template<int THRL> __device__ __forceinline__ void attn_unit(int b,int h,int qb,const bf16*Q,const bf16*__restrict__ K,const bf16*__restrict__ V,bf16*O,const u32x4*__restrict__ FC8row,int js,char*shm){
  const int tid=threadIdx.x,lane=tid&63,r32=lane&31,hi=lane>>5; const int wid=__builtin_amdgcn_readfirstlane(tid>>6);
  const long rowbase=(long)b*SEQ; const int q0=qb*QB;
  const bf16*Qw=Q+(rowbase+q0+wid*QBLK)*DM+h*D;
  const bf16*Kh=K+(rowbase+(long)js*KVBLK)*DM+h*D,*Vh=V+(rowbase+(long)js*KVBLK)*DM+h*D; FC8row+=js*(KVBLK/2);
  const unsigned lds0=(unsigned)(uintptr_t)shm;
  float*wsf=(float*)(shm+LDS_WS)+wid*64;
  typedef __attribute__((address_space(3))) u32x4* lds_u4ptr; typedef __attribute__((address_space(3))) const u32x2* lds_u2cptr;
  const lds_u2cptr bt8=(lds_u2cptr)((__attribute__((address_space(3))) const char*)shm+LDS_BIAS)+r32;
  unsigned bm1=hi?0u:0x00003F80u, bm2=0u; const unsigned bm0=hi?0u:0x3F803F80u; u32x2 ab0,ab1;
  #define BFRAG() __builtin_bit_cast(bf16x8,(u32x4){bm0,bm1,bm2,0u})
  #define AFRAG(e) __builtin_bit_cast(bf16x8,(u32x4){e[0],e[1],0x3F803F80u,0u})
  #define ABLD(t) do{ ab0=bt8[64*(t)]; ab1=bt8[64*(t)+32]; }while(0)
  #define SETB() do{ const float m_=-mhat; const unsigned h_=cvtpk_s(m_,0.f)&0xffffu; const float r1_=m_-__uint_as_float(h_<<16); const unsigned d_=cvtpk_s(r1_,0.f)&0xffffu; \
      const float r2_=r1_-__uint_as_float(d_<<16); const unsigned l_=cvtpk_s(r2_,0.f)&0xffffu; bm1=hi?0u:((h_<<16)|0x3F80u); bm2=hi?0u:((l_<<16)|d_); }while(0)
  const bf16*ksrc=Kh+(long)lane*DM+wid*8;
  const bf16*vsrc=Vh+(long)(16*(wid&3)+(lane>>2))*DM+(wid>>2)*32+(lane&3)*8;
  const unsigned kdst=lds0+LDS_K+wid*1024, vdst=lds0+LDS_V+wid*1024;
  #define DMA_K(t,slot) glds16(ksrc+(long)(t)*KVBLK*DM,(unsigned)__builtin_amdgcn_readfirstlane(kdst+(slot)))
  #define DMA_V(t,slot) glds16(vsrc+(long)(t)*KVBLK*DM,(unsigned)__builtin_amdgcn_readfirstlane(vdst+(slot)))
  const int vb0=(int)(lds0+LDS_V)+((lane>>4)&1)*32+(lane&3)*8+(4*hi+((lane&15)>>2))*64;
  const char*Kbase=shm+LDS_K; bf16x8 kf[8];
  const lds_cptr shm3=(lds_cptr)shm; const lds_cptr kp0=shm3+LDS_K+hi*1024+r32*16; const lds_cptr vp0=shm3+LDS_V+((lane>>4)&1)*32+(lane&3)*8+(4*hi+((lane&15)>>2))*64;
  const int NT=(q0+QB)/KVBLK-js;
  DMA_K(0,0);DMA_V(0,0);DMA_K(1,SLOTB);
  bf16x8 qr[4];
  #pragma unroll
  for(int d0=0;d0<4;++d0)qr[d0]=*reinterpret_cast<const bf16x8*>(&Qw[(long)r32*DM+d0*16+hi*8]);
  float mhat=0.f,l_reg=0.f;f32x16 o[2];o[0]=f32x16{};o[1]=f32x16{};const f32x16 zero16=f32x16{};
  const int qrel=wid*QBLK+r32;
  #define CMASK(P0,P1,t) do{int jb_=(t)-(NT-4); if(jb_>=0)cmask(P0,P1,jb_,qrel,hi);}while(0)
  bool resc=false;
  #define START(P0,P1) do{ const float rm=rowmax(P0,P1); resc=false; \
    { const float dl=rm; mhat=fadd_s(mhat,dl); \
      _Pragma("unroll") for(int r=0;r<16;++r){P0[r]=fsub_s(P0[r],dl);P1[r]=fsub_s(P1[r],dl);} \
      SETB(); } \
    _Pragma("unroll") for(int r=0;r<16;++r)P0[r]=__builtin_amdgcn_exp2f(P0[r]); }while(0)
  #define RESC() do{ if(resc){ asm volatile("s_waitcnt lgkmcnt(0)":::"memory"); \
      _Pragma("unroll") for(int d_=0;d_<2;++d_) _Pragma("unroll") for(int r=0;r<16;++r)o[d_][r]*=wsf[crow(r,hi)]; } }while(0)
  f32x16 pA0,pA1,pB0,pB1;
  int sl_prev=0,sl_cur=0,sl_next=SLOTB;
  #define ROT() do{sl_prev=sl_cur;sl_cur=sl_next;sl_next=(sl_next==(NSLOT-1)*SLOTB)?0:sl_next+SLOTB;}while(0)
  DMA_K(2,2*SLOTB);
    { const lds_u4ptr bt16=(lds_u4ptr)((__attribute__((address_space(3))) char*)shm+LDS_BIAS); int t0_=tid; asm volatile("":"+v"(t0_));   for(int i_=t0_;i_<((q0+QB)/KVBLK-js)*(KVBLK/2);i_+=NW*64) bt16[i_]=FC8row[i_]; }
  WAIT_BAR(3);
  ABLD(0); pA0=__builtin_amdgcn_mfma_f32_32x32x16_bf16(AFRAG(ab0),BFRAG(),zero16,0,0,0); pA1=__builtin_amdgcn_mfma_f32_32x32x16_bf16(AFRAG(ab1),BFRAG(),zero16,0,0,0);
  qkt(pA0,pA1,Kbase,qr,r32,hi);asm volatile("s_nop 15\n\ts_nop 7":"+v"(pA0),"+v"(pA1));CMASK(pA0,pA1,0);
  START(pA0,pA1);
  ABLD(1);
  _Pragma("unroll") for(int r=0;r<16;++r)pA1[r]=__builtin_amdgcn_exp2f(pA1[r]);
  WAIT_BAR(0);
  DMA_K(3,0);DMA_V(1,SLOTB);
  ROT();
  kload8(kf,kp0+sl_cur);
  WAIT_BAR(2);
  s16x4 vlo[8],vhi[8]; u32x4 pw0,pw1,pw2,pw3;
  #define PKW(P,B) cvtpk_s(P[B],P[B+1])
  #define PAF(k) __builtin_bit_cast(bf16x8,pw##k)
  #define VFR(i) (bf16x8){vlo[i][0],vlo[i][1],vlo[i][2],vlo[i][3],vhi[i][0],vhi[i][1],vhi[i][2],vhi[i][3]}
  #define PIN(x) asm volatile("":"+v"(x))
  #define MX3(a,b,c) __builtin_fmaxf(__builtin_fmaxf((a),(b)),(c))
  #define GAPA(MF,A0,A1,A2,A3,W0,W1,PW) do{ MF; sacc+=A0; sacc+=A1; sacc+=A2; sacc+=A3; PIN(sacc); W0; W1; PIN(PW); SBAR(); }while(0)
  #define EX(v) __builtin_amdgcn_exp2f(v)
  #define GAPB(MF,X,B) do{ MF; X[B]=EX(X[B]); X[B+1]=EX(X[B+1]); X[B+2]=EX(X[B+2]); X[B+3]=EX(X[B+3]); PIN(X); SBAR(); }while(0)
  #define VRD(i) do{ vlo[i]=vtr(vp_+(((i)>>2)*4096+((i)&3)*1024)); vhi[i]=vtr(vp_+(((i)>>2)*4096+((i)&3)*1024+512)); }while(0)
  #define KRD(G,j) do{ if(G){ kload2(kf,kp0+sl_next,j); SBAR(); } }while(0)
  #define STEP(C0,C1,P0,P1,t,GK,GV,GL) do{ SBAR(); \
    const lds_cptr vp_=vp0+sl_prev; \
    C0=__builtin_amdgcn_mfma_f32_32x32x16_bf16(AFRAG(ab0),BFRAG(),zero16,0,0,0); C1=__builtin_amdgcn_mfma_f32_32x32x16_bf16(AFRAG(ab1),BFRAG(),zero16,0,0,0); \
    VRD(0); SBAR(); float sacc=(P0[0]+P0[1]); \
    GAPA(C0=__builtin_amdgcn_mfma_f32_32x32x16_bf16(kf[0],qr[0],C0,0,0,0), P0[2],P0[3],P0[4],P0[5],     pw0[0]=PKW(P0,0), pw0[1]=PKW(P0,2), pw0); \
    VRD(4); SBAR(); GAPA(C1=__builtin_amdgcn_mfma_f32_32x32x16_bf16(kf[1],qr[0],C1,0,0,0), P0[6],P0[7],P0[8],P0[9],     pw0[2]=PKW(P0,4), pw0[3]=PKW(P0,6), pw0); \
    VRD(1); SBAR(); GAPA(C0=__builtin_amdgcn_mfma_f32_32x32x16_bf16(kf[2],qr[1],C0,0,0,0),   P0[10],P0[11],P0[12],P0[13], pw1[0]=PKW(P0,8), pw1[1]=PKW(P0,10), pw1); \
    VRD(5); SBAR(); GAPA(C1=__builtin_amdgcn_mfma_f32_32x32x16_bf16(kf[3],qr[1],C1,0,0,0),   P0[14],P0[15],P1[0],P1[1],   pw1[2]=PKW(P0,12),pw1[3]=PKW(P0,14), pw1); \
    VRD(2); SBAR(); GAPA(C0=__builtin_amdgcn_mfma_f32_32x32x16_bf16(kf[4],qr[2],C0,0,0,0),   P1[2],P1[3],P1[4],P1[5],     pw2[0]=PKW(P1,0), pw2[1]=PKW(P1,2), pw2); \
    VRD(6); SBAR(); GAPA(C1=__builtin_amdgcn_mfma_f32_32x32x16_bf16(kf[5],qr[2],C1,0,0,0),   P1[6],P1[7],P1[8],P1[9],     pw2[2]=PKW(P1,4), pw2[3]=PKW(P1,6), pw2); \
    VRD(3); SBAR(); GAPA(C0=__builtin_amdgcn_mfma_f32_32x32x16_bf16(kf[6],qr[3],C0,0,0,0),   P1[10],P1[11],P1[12],P1[13], pw3[0]=PKW(P1,8), pw3[1]=PKW(P1,10), pw3); \
    VRD(7); SBAR(); GAPA(C1=__builtin_amdgcn_mfma_f32_32x32x16_bf16(kf[7],qr[3],C1,0,0,0),   P1[14],P1[15],0.f,0.f,       pw3[2]=PKW(P1,12),pw3[3]=PKW(P1,14), pw3); \
    l_reg+=sacc; \
    if(GK){DMA_K((t)+3,sl_cur);} if(GV){DMA_V((t)+1,sl_next);} \
    CMASK(C0,C1,t); \
    { float a=MX3(C0[0],C0[1],C1[0]),b=MX3(C0[2],C0[3],C1[1]); a=MX3(a,C1[2],C1[3]); \
      _Pragma("unroll") for(int r=4;r<16;r+=4){a=MX3(a,C0[r],C0[r+1]);b=MX3(b,C0[r+2],C0[r+3]);a=MX3(a,C1[r],C1[r+1]);b=MX3(b,C1[r+2],C1[r+3]);} \
      float rm=__builtin_fmaxf(a,b); { auto rr=__builtin_amdgcn_permlane32_swap(__float_as_uint(rm),__float_as_uint(rm),false,false); rm=__builtin_fmaxf(__uint_as_float(rr[0]),__uint_as_float(rr[1])); } \
      resc=false; \
      if(__builtin_expect(__any(rm>(float)THRL),0)){ const float dl=__builtin_fmaxf(rm,0.f); mhat+=dl; \
        _Pragma("unroll") for(int r=0;r<16;++r){C0[r]-=dl;C1[r]-=dl;} \
        SETB(); \
        const float f=__builtin_amdgcn_exp2f(-dl); l_reg*=f; if(hi==0)wsf[r32]=f; resc=true; } } \
    if(GL){ ABLD((t)+1); } \
    SBAR(); \
    GAPB(o[0]=__builtin_amdgcn_mfma_f32_32x32x16_bf16(PAF(0),VFR(0),o[0],0,0,0), C0,0); \
    GAPB(o[1]=__builtin_amdgcn_mfma_f32_32x32x16_bf16(PAF(0),VFR(4),o[1],0,0,0), C0,4); \
    KRD(GL,0); GAPB(o[0]=__builtin_amdgcn_mfma_f32_32x32x16_bf16(PAF(1),VFR(1),o[0],0,0,0), C0,8); \
    KRD(GL,1); GAPB(o[1]=__builtin_amdgcn_mfma_f32_32x32x16_bf16(PAF(1),VFR(5),o[1],0,0,0), C0,12); \
    KRD(GL,2); GAPB(o[0]=__builtin_amdgcn_mfma_f32_32x32x16_bf16(PAF(2),VFR(2),o[0],0,0,0), C1,0); \
    KRD(GL,3); GAPB(o[1]=__builtin_amdgcn_mfma_f32_32x32x16_bf16(PAF(2),VFR(6),o[1],0,0,0), C1,4); \
    GAPB(o[0]=__builtin_amdgcn_mfma_f32_32x32x16_bf16(PAF(3),VFR(3),o[0],0,0,0), C1,8); \
    GAPB(o[1]=__builtin_amdgcn_mfma_f32_32x32x16_bf16(PAF(3),VFR(7),o[1],0,0,0), C1,12); \
    }while(0)
  int t=1;
  #undef CMASK
  #define CMASK(P0,P1,t) do{}while(0)
  for(;t+5<NT;t+=2){
    STEP(pB0,pB1,pA0,pA1,t,true,true,true);     WAIT_BAR(2); RESC(); ROT();
    STEP(pA0,pA1,pB0,pB1,t+1,true,true,true);   WAIT_BAR(2); RESC(); ROT();
  }
  #undef CMASK
  #define CMASK(P0,P1,t) do{int jb_=(t)-(NT-4); if(jb_>=0)cmask(P0,P1,jb_,qrel,hi);}while(0)
  #define ENDW(tt) do{ if((tt)+3<NT){WAIT_BAR(2);} else if((tt)+2<NT){WAIT_BAR(1);} else {WAIT_BAR(0);} }while(0)
  for(;t+1<NT;t+=2){
    STEP(pB0,pB1,pA0,pA1,t,(t+3<NT),(t+1<NT),(t+1<NT));       ENDW(t);   RESC(); ROT();
    STEP(pA0,pA1,pB0,pB1,t+1,(t+4<NT),(t+2<NT),(t+2<NT));     ENDW(t+1); RESC(); ROT();
  }
  STEP(pB0,pB1,pA0,pA1,NT-1,false,false,false); RESC();
  { float sacc=pB0[0]+pB0[1]; _Pragma("unroll") for(int r=2;r<16;++r)sacc+=pB0[r]; _Pragma("unroll") for(int r=0;r<16;++r)sacc+=pB1[r]; l_reg+=sacc;
    pw0=(u32x4){PKW(pB0,0),PKW(pB0,2),PKW(pB0,4),PKW(pB0,6)};pw1=(u32x4){PKW(pB0,8),PKW(pB0,10),PKW(pB0,12),PKW(pB0,14)};pw2=(u32x4){PKW(pB1,0),PKW(pB1,2),PKW(pB1,4),PKW(pB1,6)};pw3=(u32x4){PKW(pB1,8),PKW(pB1,10),PKW(pB1,12),PKW(pB1,14)};
    SBAR(); pv(o,vb0+sl_cur,PAF(0),PAF(1),PAF(2),PAF(3)); }
  #undef PKW
  #undef PAF
  #undef VFR
  #undef PIN
  #undef MX3
  #undef GAPA
  #undef GAPB
  #undef EX
  #undef VRD
  #undef KRD
  #undef STEP
  #undef ENDW
  {auto rr=__builtin_amdgcn_permlane32_swap(__float_as_uint(l_reg),__float_as_uint(l_reg),false,false);l_reg=__uint_as_float(rr[0])+__uint_as_float(rr[1]);}
  if(hi==0)wsf[32+r32]=l_reg;asm volatile("s_waitcnt lgkmcnt(0)":::"memory");
  float rli[16];
  #pragma unroll
  for(int r=0;r<16;++r)rli[r]=__builtin_amdgcn_rcpf(wsf[32+crow(r,hi)]);
  bf16*Ow=O+(rowbase+q0+wid*QBLK)*DM+h*D;
  { bf16*stg=(bf16*)(shm+LDS_OST)+wid*2048;
    #pragma unroll
    for(int r=0;r<16;++r){const int orow=crow(r,hi);
      #pragma unroll
      for(int d0=0;d0<2;++d0)stg[orow*64+d0*32+r32]=__float2bfloat16(o[d0][r]*rli[r]);}
    asm volatile("s_waitcnt lgkmcnt(0)":::"memory");
    #pragma unroll
    for(int i=0;i<4;++i){const int row=i*8+(lane>>3),ch=lane&7; const u32x4 v=*(const u32x4*)(stg+row*64+ch*8); ATTN_STORE16(Ow+(long)row*DM+ch*8,v);} }
  asm volatile("s_waitcnt lgkmcnt(0)\n\ts_barrier":::"memory");
  #undef DMA_K
  #undef DMA_V
  #undef BFRAG
  #undef AFRAG
  #undef ABLD
  #undef SETB
  #undef CMASK
  #undef START
  #undef RESC
  #undef ROT
}
constexpr int ATTN_LDS_BYTES=LDS_BYTES;
#undef SBAR
#undef WAIT_BAR
}
constexpr int NWAVES = 8;
constexpr int TOK = 8 * 4096, DM = 1024, DFF = 2816, SEQL = 4096;
constexpr int N_GU = 2 * DFF, N_EVIN = 2560  , N_ODIN = 3072;
constexpr size_t MiB = 1u << 20;
constexpr size_t GU_BYTES = (size_t)N_GU * DM * 2, DN_BYTES = (size_t)DM * DFF * 2;
constexpr size_t WS_WGU = 2 * MiB;
constexpr size_t WS_WDN = WS_WGU + 4 * GU_BYTES;
constexpr size_t WS_WEVIN = WS_WDN + 4 * DN_BYTES;
constexpr size_t WS_WEVOUT = WS_WEVIN + (size_t)N_EVIN * DM * 2;
constexpr size_t WS_WODIN = WS_WEVOUT + (size_t)DM * DM * 2;
constexpr size_t WS_WODOUT = WS_WODIN + (size_t)N_ODIN * DM * 2;
constexpr size_t WS_WEND = WS_WODOUT + (size_t)DM * DM * 2;
static_assert(WS_WEND <= 88 * MiB, "weights");
constexpr size_t WS_SSP = 88 * MiB;
constexpr size_t WS_LF = 90 * MiB, WS_FC = 91 * MiB;
constexpr size_t WS_FC8 = 92 * MiB;
constexpr size_t WS_XB = 96 * MiB;
constexpr size_t WS_H = 160 * MiB;
constexpr size_t WS_QK = 160 * MiB, WS_VA = 224 * MiB, WS_CAT = 288 * MiB;
constexpr size_t WS_END = 352 * MiB;
constexpr int LDS_BYTES = 147456;
constexpr int MISC_OFF = 131072 + 320;
constexpr size_t WS_CTL = 0, CTL_ZERO_BYTES = 65536; constexpr int CW_BAR = 4096; constexpr int CW_QUEUE = 8192;
constexpr int N_PHASES = 16;

#define GAS __attribute__((address_space(1)))
#define LAS __attribute__((address_space(3)))
typedef unsigned short bf16;
typedef unsigned v4u __attribute__((ext_vector_type(4)));
typedef float f32x4 __attribute__((ext_vector_type(4)));
#define LDS_WAIT() asm volatile("s_waitcnt lgkmcnt(0)" ::: "memory")
__device__ __forceinline__ unsigned pk2(float lo, float hi) { return pg8::cvt_pk_bf16(lo, hi); }
__device__ __forceinline__ float bf_lo(unsigned w) { return __uint_as_float(w << 16); }
__device__ __forceinline__ float bf_hi(unsigned w) { return __uint_as_float(w & 0xffff0000u); }
__device__ __forceinline__ float wave_sum(float v) {
#pragma unroll
    for (int o = 1; o < 64; o <<= 1) v += __shfl_xor(v, o);
    return v;
}

struct Args { const float* in[21]; float* out; unsigned char* ws; int ph_lo, ph_hi; };
struct P0Item { const float* src; const float* gain; bf16* dst; int N, col0, nvalid, K, drow0, k0; };
__device__ __forceinline__ void p0_load(const P0Item& d, f32x4 (&v)[8], int lane) {
    const int kr = lane >> 3, c4 = (lane & 7) * 4;
#pragma unroll
    for (int i = 0; i < 8; ++i) { const int kk = 8 * i + kr; v[i] = (f32x4){0.f, 0.f, 0.f, 0.f};
        if (c4 < d.nvalid) { v[i] = __builtin_nontemporal_load((const f32x4*)(d.src + (size_t)(d.k0 + kk) * d.N + d.col0 + c4)); if (d.gain) v[i] = v[i] * d.gain[d.k0 + kk]; } }
}
__device__ __forceinline__ void p0_store(const P0Item& d, const f32x4 (&v)[8], LAS float* scr, int lane) {
    const int kr = lane >> 3, c4 = (lane & 7) * 4;
#pragma unroll
    for (int i = 0; i < 8; ++i) { LAS float* s = scr + (8 * i + kr) * 33 + c4; s[0] = v[i][0]; s[1] = v[i][1]; s[2] = v[i][2]; s[3] = v[i][3]; }
    LDS_WAIT(); asm volatile("" ::: "memory");
    const int c8 = lane & 7;
#pragma unroll
    for (int j = 0; j < 4; ++j) { const int n = (lane >> 3) + 8 * j; const LAS float* s = scr + (8 * c8) * 33 + n;
        v4u o; o.x = pk2(s[0 * 33], s[1 * 33]); o.y = pk2(s[2 * 33], s[3 * 33]); o.z = pk2(s[4 * 33], s[5 * 33]); o.w = pk2(s[6 * 33], s[7 * 33]);
        *(v4u*)(d.dst + (size_t)(d.drow0 + n) * d.K + d.k0 + 8 * c8) = o; }
    LDS_WAIT(); asm volatile("" ::: "memory");
}
constexpr int I_GU = (DM / 64) * (N_GU / 32), I_DN = (DFF / 64) * (DM / 32), I_EVIN = (DM / 64) * (N_EVIN / 32), I_OUT = (DM / 64) * (DM / 32), I_ODIN = (DM / 64) * (N_ODIN / 32);
constexpr int P0_NITEMS = 4 * I_GU + 4 * I_DN + I_EVIN + I_OUT + I_ODIN + I_OUT;
__device__ __forceinline__ P0Item p0_decode(const Args& A, int it) {
    unsigned char* ws = A.ws; P0Item d; int r = it; d.nvalid = 32; d.gain = nullptr; d.K = DM;
    if (r < 4 * I_GU) { const int w = r / I_GU; r -= w * I_GU; const int layer = w >> 1, second = w & 1;
        const int nbn = N_GU / 32, kb = r / nbn, nb = r % nbn, pn = nb >> 3, bj = (nb >> 2) & 1, c0 = (nb & 3) * 32;
        const float* gsrc = second ? A.in[7] : A.in[2]; const float* usrc = second ? A.in[8] : A.in[3]; const float* nsrc = second ? A.in[6] : A.in[1];
        d.src = (bj ? usrc : gsrc) + (size_t)layer * DM * DFF; d.gain = nsrc + layer * DM; d.N = DFF; d.col0 = 128 * pn + c0;
        d.dst = (bf16*)(ws + WS_WGU + w * GU_BYTES); d.drow0 = 32 * nb; d.k0 = 64 * kb; return d; }
    r -= 4 * I_GU;
    if (r < 4 * I_DN) { const int w = r / I_DN; r -= w * I_DN; const int layer = w >> 1, second = w & 1;
        const int nbn = DM / 32, kb = r / nbn, nb = r % nbn;
        d.src = (second ? A.in[9] : A.in[4]) + (size_t)layer * DFF * DM; d.N = DM; d.col0 = 32 * nb; d.K = DFF;
        d.dst = (bf16*)(ws + WS_WDN + w * DN_BYTES); d.drow0 = 32 * nb; d.k0 = 64 * kb; return d; }
    r -= 4 * I_DN;
    if (r < I_EVIN) { const int nbn = N_EVIN / 32, kb = r / nbn, nb = r % nbn, pn = nb >> 3, bj = (nb >> 2) & 1, wc = nb & 3; int col0;
        if (pn < 4) col0 = (bj ? 512 : 0) + 128 * pn + 32 * wc;
        else if (pn < 8) col0 = (pn < 6 ? 1024 : 1536) + (4 * (pn & 1) + wc) * 64 + 32 * bj;
        else if (pn < 10) col0 = 2048 + 256 * (pn - 8) + 128 * bj + 32 * wc;
        else { col0 = 2560; d.nvalid = (nb == 80) ? 8 : 0; }
        d.src = A.in[10]; d.gain = A.in[5]; d.N = 2568; d.col0 = col0; d.dst = (bf16*)(ws + WS_WEVIN); d.drow0 = 32 * nb; d.k0 = 64 * kb; return d; }
    r -= I_EVIN;
    if (r < I_OUT) { const int nbn = DM / 32, kb = r / nbn, nb = r % nbn;
        d.src = A.in[17]; d.N = DM; d.col0 = 32 * nb; d.dst = (bf16*)(ws + WS_WEVOUT); d.drow0 = 32 * nb; d.k0 = 64 * kb; return d; }
    r -= I_OUT;
    if (r < I_ODIN) { const int nbn = N_ODIN / 32, kb = r / nbn, nb = r % nbn, pn = nb >> 3, bj = (nb >> 2) & 1, wc = nb & 3;
        d.col0 = (pn < 8) ? (bj ? 2048 : 1024) + 128 * pn + 32 * wc : 256 * (pn - 8) + 128 * bj + 32 * wc;
        d.src = A.in[18]; d.gain = A.in[5] + DM; d.N = N_ODIN; d.dst = (bf16*)(ws + WS_WODIN); d.drow0 = 32 * nb; d.k0 = 64 * kb; return d; }
    r -= I_ODIN;
    { const int nbn = DM / 32, kb = r / nbn, nb = r % nbn;
        d.src = A.in[20]; d.N = DM; d.col0 = 32 * nb; d.dst = (bf16*)(ws + WS_WODOUT); d.drow0 = 32 * nb; d.k0 = 64 * kb; return d; }
}

constexpr int P0_EARLY = I_GU + I_DN, SHADOW_N = P0_NITEMS - P0_EARLY, SHADOW_PER_SEAM = 256 * (NWAVES - 1);
__device__ __forceinline__ int early_item_id(int j) { return j < I_GU ? j : 4 * I_GU + (j - I_GU); }
__device__ __forceinline__ int shadow_item_id(int j) {
    constexpr int B0 = 4 * I_GU + 4 * I_DN;
    if (j < I_EVIN) return B0 + j; j -= I_EVIN;
    if (j < I_OUT) return B0 + I_EVIN + j; j -= I_OUT;
    if (j < I_GU) return I_GU + j; j -= I_GU;
    if (j < I_DN) return 4 * I_GU + I_DN + j; j -= I_DN;
    if (j < I_GU) return 2 * I_GU + j; j -= I_GU;
    if (j < I_DN) return 4 * I_GU + 2 * I_DN + j; j -= I_DN;
    if (j < I_ODIN) return B0 + I_EVIN + I_OUT + j; j -= I_ODIN;
    if (j < I_OUT) return B0 + I_EVIN + I_OUT + I_ODIN + j; j -= I_OUT;
    if (j < I_GU) return 3 * I_GU + j; j -= I_GU;
    return 4 * I_GU + 3 * I_DN + j;
}
static_assert(I_EVIN <= 1 * SHADOW_PER_SEAM && I_EVIN + I_OUT <= 4 * SHADOW_PER_SEAM && I_EVIN + I_OUT + I_GU <= 5 * SHADOW_PER_SEAM && I_EVIN + I_OUT + I_GU + I_DN <= 6 * SHADOW_PER_SEAM &&
              I_EVIN + I_OUT + 2 * I_GU + I_DN <= 7 * SHADOW_PER_SEAM && I_EVIN + I_OUT + 2 * I_GU + 2 * I_DN <= 8 * SHADOW_PER_SEAM && I_EVIN + I_OUT + 2 * I_GU + 2 * I_DN + I_ODIN <= 9 * SHADOW_PER_SEAM &&
              I_EVIN + 2 * I_OUT + 2 * I_GU + 2 * I_DN + I_ODIN <= 11 * SHADOW_PER_SEAM && I_EVIN + 2 * I_OUT + 3 * I_GU + 2 * I_DN + I_ODIN <= 12 * SHADOW_PER_SEAM && SHADOW_N <= 13 * SHADOW_PER_SEAM, "shadow conversion deadlines");
__device__ __forceinline__ void p0_prologue(const Args& A, LAS unsigned char* lds, int gw, int NGW, int wave, int lane, bool deferred) {
    LAS float* scr = (LAS float*)(lds + wave * 16384);
    unsigned char* ws = A.ws;
    { const int NIT = deferred ? P0_EARLY : P0_NITEMS;
#define P0_ID(i_) (deferred ? early_item_id(i_) : (i_))
      int it = gw; P0Item d; f32x4 v[8];
      if (it < NIT) { d = p0_decode(A, P0_ID(it)); p0_load(d, v, lane); }
      while (it < NIT) { const int nit = it + NGW; P0Item dn = d; f32x4 vn[8];
#pragma unroll
          for (int i = 0; i < 8; ++i) vn[i] = v[i];
          if (nit < NIT) { dn = p0_decode(A, P0_ID(nit)); p0_load(dn, vn, lane); }
          p0_store(d, v, scr, lane); d = dn;
#pragma unroll
          for (int i = 0; i < 8; ++i) v[i] = vn[i];
          it = nit; }
#undef P0_ID
    }
    const float* x = A.in[0]; bf16* XB = (bf16*)(ws + WS_XB); float* ssp = (float*)(ws + WS_SSP);
    for (int m = gw; m < TOK; m += NGW) {
        const f32x4* xr = (const f32x4*)(x + (size_t)m * DM) + lane; f32x4 v[4]; float s = 0.f;
#pragma unroll
        for (int j = 0; j < 4; ++j) { v[j] = __builtin_nontemporal_load(xr + 64 * j); s += (v[j].x * v[j].x + v[j].y * v[j].y) + (v[j].z * v[j].z + v[j].w * v[j].w); }
        s = wave_sum(s);
        unsigned long long* o8 = (unsigned long long*)(XB + (size_t)m * DM) + lane;
#pragma unroll
        for (int j = 0; j < 4; ++j) o8[64 * j] = (unsigned long long)pk2(v[j].x, v[j].y) | ((unsigned long long)pk2(v[j].z, v[j].w) << 32);
        if (lane < 16) ssp[(size_t)m * 16 + lane] = (lane == 0) ? s : 0.f;
    }
}

__device__ __forceinline__ void forget_mfma(const Args& A, LAS unsigned char* lds, int vcu, int G, int tid, int wave, int lane) {
    typedef short bf16x8f __attribute__((ext_vector_type(8))); typedef float f32x16f __attribute__((ext_vector_type(16)));
    constexpr int WP = 1032;
    unsigned char* ws = A.ws; LAS bf16* Wt = (LAS bf16*)lds; LAS float* rsl = (LAS float*)(lds + 8 * WP * 2) + wave * 32;
    { const float* W = A.in[10]; const float* gain = A.in[5];
      for (int k = tid; k < DM; k += NWAVES * 64) { const f32x4 a = *(const f32x4*)(W + (size_t)k * 2568 + 2560), b = *(const f32x4*)(W + (size_t)k * 2568 + 2564); const float g = gain[k];
          Wt[0 * WP + k] = (bf16)(pk2(a.x * g, 0.f) & 0xffffu); Wt[1 * WP + k] = (bf16)(pk2(a.y * g, 0.f) & 0xffffu); Wt[2 * WP + k] = (bf16)(pk2(a.z * g, 0.f) & 0xffffu); Wt[3 * WP + k] = (bf16)(pk2(a.w * g, 0.f) & 0xffffu);
          Wt[4 * WP + k] = (bf16)(pk2(b.x * g, 0.f) & 0xffffu); Wt[5 * WP + k] = (bf16)(pk2(b.y * g, 0.f) & 0xffffu); Wt[6 * WP + k] = (bf16)(pk2(b.z * g, 0.f) & 0xffffu); Wt[7 * WP + k] = (bf16)(pk2(b.w * g, 0.f) & 0xffffu); } }
    __syncthreads();
    const bf16* XB = (const bf16*)(ws + WS_XB); const float* ssp = (const float*)(ws + WS_SSP); float* LF = (float*)(ws + WS_LF); const float* bfp = A.in[11];
    const int r32 = lane & 31, hi = lane >> 5;
    for (int task = wave * G + vcu; task < TOK / 32; task += G * NWAVES) {
        const int row0 = task * 32;
        if (lane < 32) { const f32x4* p = (const f32x4*)(ssp + (size_t)(row0 + lane) * 16); const f32x4 a = p[0], b = p[1], c = p[2], d = p[3];
            const float s = (((a[0] + a[1]) + (a[2] + a[3])) + ((b[0] + b[1]) + (b[2] + b[3]))) + (((c[0] + c[1]) + (c[2] + c[3])) + ((d[0] + d[1]) + (d[2] + d[3])));
            rsl[lane] = __builtin_amdgcn_rsqf(s * (1.0f / 1024.0f) + pg8::RMS_EPS); }
        f32x16f acc = f32x16f{};
        const bf16* xrow = XB + (size_t)(row0 + r32) * DM + 8 * hi; const LAS bf16* wrow = Wt + (r32 & 7) * WP + 8 * hi;
#pragma unroll 1
        for (int s0 = 0; s0 < 64; s0 += 16) { bf16x8f a[16];
#pragma unroll
            for (int j = 0; j < 16; ++j) a[j] = *(const bf16x8f*)(xrow + 16 * (s0 + j));
#pragma unroll
            for (int j = 0; j < 16; ++j) { bf16x8f b = *(const LAS bf16x8f*)(wrow + 16 * (s0 + j)); if (r32 >= 8) b = bf16x8f{};
                acc = __builtin_amdgcn_mfma_f32_32x32x16_bf16(a[j], b, acc, 0, 0, 0); } }
        LDS_WAIT();
        if (r32 < 8) { const float bb = bfp[r32];
#pragma unroll
            for (int r = 0; r < 16; ++r) { const int rr = (r & 3) + 8 * (r >> 2) + 4 * hi, row = row0 + rr; const float z = acc[r] * rsl[rr] + bb;
                LF[(size_t)((row >> 12) * 8 + r32) * SEQL + (row & (SEQL - 1))] = fminf(z, 0.f) - log1pf(__expf(-fabsf(z))); } }
        LDS_WAIT(); asm volatile("" ::: "memory");
    }
}
__device__ __forceinline__ void prep_even(const Args& A, LAS unsigned char* lds, int vcu, int G, int tid, int wave, int lane) {
    unsigned char* ws = A.ws;
    if (wave == 0 && vcu < 64) {
        const int gw = vcu; const f32x4* lf4 = (const f32x4*)((const float*)(ws + WS_LF) + (size_t)gw * SEQL) + lane * 16; f32x4 v[16];
#pragma unroll
        for (int i = 0; i < 16; ++i) v[i] = lf4[i];
        float run = 0.f;
#pragma unroll
        for (int i = 0; i < 16; ++i) { v[i].x += run; v[i].y += v[i].x; v[i].z += v[i].y; v[i].w += v[i].z; run = v[i].w; }
        float incl = run;
#pragma unroll
        for (int o = 1; o < 64; o <<= 1) { const float t = __shfl_up(incl, o); if (lane >= o) incl += t; }
        const float base = incl - run;
        f32x4* fc4 = (f32x4*)((float*)(ws + WS_FC) + (size_t)gw * SEQL) + lane * 16; v4u* f8 = (v4u*)((unsigned long long*)(ws + WS_FC8) + (size_t)gw * SEQL) + lane * 32;
#pragma unroll
        for (int i = 0; i < 16; ++i) { f32x4 bb = (v[i] + base) * (-pg8::LOG2E); fc4[i] = bb; unsigned lo_[4], hi_[4];
#pragma unroll
            for (int j = 0; j < 4; ++j) { const float x = bb[j]; const unsigned h_ = pk2(x, 0.f) & 0xffffu; const float r1 = x - __uint_as_float(h_ << 16); const unsigned d_ = pk2(r1, 0.f) & 0xffffu;
                const float r2 = r1 - __uint_as_float(d_ << 16); const unsigned l_ = pk2(r2, 0.f) & 0xffffu; lo_[j] = h_ | (d_ << 16); hi_[j] = l_ | 0x3F800000u; }
            f8[2 * i] = (v4u){lo_[0], hi_[0], lo_[1], hi_[1]}; f8[2 * i + 1] = (v4u){lo_[2], hi_[2], lo_[3], hi_[3]}; }
    }
    const bf16* VA = (const bf16*)(ws + WS_VA); bf16* CAT = (bf16*)(ws + WS_CAT);
    const float* cw = A.in[12]; const float* cb = A.in[13]; const float* cn = A.in[14];
    const int cp = tid & 255, th = tid >> 8;
    typedef float f32x2p __attribute__((ext_vector_type(2)));
    f32x2p wk[31];
#pragma unroll
    for (int k = 0; k < 31; ++k) wk[k] = *(const f32x2p*)(cw + k * 512 + 2 * cp);
    const float b0 = cb[2 * cp], b1 = cb[2 * cp + 1], g0 = cn[2 * cp], g1 = cn[2 * cp + 1];
    LAS unsigned* tile = (LAS unsigned*)lds;
    typedef float f32x2w __attribute__((ext_vector_type(2)));
    LAS f32x2w* outb = (LAS f32x2w*)(lds + 62 * 1024);
    LAS float* red = (LAS float*)(lds + 62 * 1024 + 65536);
    LAS float* rst = red + 128;
#define CONV_LOAD(tl_, buf) do { const int row0_ = (tl_) * 32, t0_ = row0_ & (SEQL - 1); _Pragma("unroll") for (int k_ = 0; k_ < 8; ++k_) { const int c_ = tid + k_ * NWAVES * 64; const int r_ = c_ >> 6, ch_ = c_ & 63; buf[k_] = (v4u){0u, 0u, 0u, 0u}; \
        if (c_ < 62 * 64 && t0_ + r_ - 30 >= 0) buf[k_] = *(const v4u*)(VA + (size_t)(row0_ + r_ - 30) * 1024 + 512 + ch_ * 8); } } while (0)
#define CONV_STORE(buf) do { _Pragma("unroll") for (int k_ = 0; k_ < 8; ++k_) { const int c_ = tid + k_ * NWAVES * 64; if (c_ < 62 * 64) *(LAS v4u*)(tile + (c_ >> 6) * 256 + (c_ & 63) * 4) = buf[k_]; } } while (0)
    v4u cur[8]; int tl = vcu; if (tl < TOK / 32) CONV_LOAD(tl, cur);
    while (tl < TOK / 32) {
        const int row0 = tl * 32;
        CONV_STORE(cur);
        __syncthreads();
        const int tn = tl + G; if (tn < TOK / 32) CONV_LOAD(tn, cur);
#pragma unroll 1
        for (int g = 0; g < 2; ++g) {
            f32x2p av[8];
#pragma unroll
            for (int j = 0; j < 8; ++j) av[j] = (f32x2p){b0, b1};
            const LAS unsigned* tp = tile + (th * 16 + g * 8) * 256 + cp;
#pragma unroll
            for (int i = 0; i < 38; ++i) { const unsigned w = tp[i * 256]; const f32x2p xv = (f32x2p){bf_lo(w), bf_hi(w)};
#pragma unroll
                for (int j = 0; j < 8; ++j) { const int k = i - j; if (k >= 0 && k < 31) av[j] = __builtin_elementwise_fma(wk[k], xv, av[j]); } }
#pragma unroll
            for (int j = 0; j < 8; ++j) { const int tt = th * 16 + g * 8 + j; outb[tt * 256 + cp] = (f32x2w){av[j].x, av[j].y};
                const float s = wave_sum(av[j].x * av[j].x + av[j].y * av[j].y); if (lane == 0) red[tt * 4 + (wave & 3)] = s; }
        }
        __syncthreads();
        if (tid < 32) { const float s = (red[tid * 4] + red[tid * 4 + 1]) + (red[tid * 4 + 2] + red[tid * 4 + 3]); rst[tid] = __builtin_amdgcn_rsqf(s * (1.0f / 512.0f) + pg8::RMS_EPS); }
        __syncthreads();
#pragma unroll 4
        for (int q = 0; q < 16; ++q) { const int tt = th * 16 + q; const float rs = rst[tt]; const f32x2w v = outb[tt * 256 + cp];
            *(unsigned*)(CAT + (size_t)(row0 + tt) * 1024 + 2 * cp) = pk2(pg8::silu_f(v.x * rs * g0), pg8::silu_f(v.y * rs * g1)); }
        __syncthreads();
        tl = tn;
    }
#undef CONV_LOAD
#undef CONV_STORE
}
__device__ __forceinline__ void conv_odd(const Args& A, int vcu, int G, int tid) {
    unsigned char* ws = A.ws;
    const bf16* __restrict__ GB = (const bf16*)(ws + WS_QK); const bf16* __restrict__ CC = (const bf16*)(ws + WS_VA); bf16* __restrict__ Y = (bf16*)(ws + WS_CAT);
    const float* w = A.in[19];
    const int sr = tid >> 7, ch = (tid & 127) * 8;
    f32x4 wa[3], wb[3];
#pragma unroll
    for (int k = 0; k < 3; ++k) { wa[k] = *(const f32x4*)(w + k * 1024 + ch); wb[k] = *(const f32x4*)(w + k * 1024 + ch + 4); }
    for (int tl = vcu; tl < TOK / 128; tl += G) {
        const int r0 = tl * 128 + sr * 32, t0 = r0 & (SEQL - 1);
        v4u c0 = (v4u){0u, 0u, 0u, 0u}, c1 = c0;
        if (t0 >= 2) c0 = *(const v4u*)(CC + (size_t)(r0 - 2) * 1024 + ch);
        if (t0 >= 1) c1 = *(const v4u*)(CC + (size_t)(r0 - 1) * 1024 + ch);
#pragma unroll 1
        for (int i = 0; i < 32; i += 4) {
            v4u cc[4], gb[4];
#pragma unroll
            for (int j = 0; j < 4; ++j) { cc[j] = *(const v4u*)(CC + (size_t)(r0 + i + j) * 1024 + ch); gb[j] = *(const v4u*)(GB + (size_t)(r0 + i + j) * 1024 + ch); }
#pragma unroll
            for (int j = 0; j < 4; ++j) { const v4u c2 = cc[j], g = gb[j]; v4u o;
#define ODD_PAIR(q, W, e0, e1) pk2(bf_lo(g.q) * (W[0][e0] * bf_lo(c0.q) + W[1][e0] * bf_lo(c1.q) + W[2][e0] * bf_lo(c2.q)), bf_hi(g.q) * (W[0][e1] * bf_hi(c0.q) + W[1][e1] * bf_hi(c1.q) + W[2][e1] * bf_hi(c2.q)))
                o.x = ODD_PAIR(x, wa, 0, 1); o.y = ODD_PAIR(y, wa, 2, 3); o.z = ODD_PAIR(z, wb, 0, 1); o.w = ODD_PAIR(w, wb, 2, 3);
#undef ODD_PAIR
                *(v4u*)(Y + (size_t)(r0 + i + j) * 1024 + ch) = o; c0 = c1; c1 = c2; }
        }
    }
}

#define XB_TMO      128
#define XB_XCNT(j)  (256  + 64 * (j))
#define XB_XSUB(j)  (1280 + 64 * (j))
#define XB_XGEN(j)  (2304 + 64 * (j))
#define XB_TOP      3328
#define XB_TOPGEN   3392
#define XCD_BAR_WORDS 3456
#define XB_SPIN_CAP (1u << 18)

__device__ __forceinline__ unsigned xb_ld(unsigned* p)              { return __hip_atomic_load(p, __ATOMIC_RELAXED, __HIP_MEMORY_SCOPE_AGENT); }
__device__ __forceinline__ unsigned xb_add(unsigned* p, unsigned v) { return __hip_atomic_fetch_add(p, v, __ATOMIC_RELAXED, __HIP_MEMORY_SCOPE_AGENT); }
__device__ __forceinline__ unsigned xb_xcc_id() { return (unsigned)__builtin_amdgcn_s_getreg((3 << 11) | 20) & 0xFu; }
#define XB_SPIN(cond, bar) do { unsigned _sp = 0; while (cond) { __builtin_amdgcn_s_sleep(1); \
    if ((++_sp & 255u) == 0u) { if (xb_ld(&(bar)[XB_TMO])) break; if (_sp > XB_SPIN_CAP) { atomicAdd(&(bar)[XB_TMO], 1u); break; } } } } while (0)

struct XcdBarrier {
    unsigned* bar; unsigned x;
    volatile LAS unsigned* st;
};

__device__ __forceinline__ XcdBarrier xcd_barrier_post(unsigned* bar, volatile LAS unsigned* st) {
    XcdBarrier b; b.bar = bar; b.x = xb_xcc_id(); b.st = st;
    if (threadIdx.x == 0) (void)xb_add(&bar[XB_XCNT(b.x)], 1u);
    return b;
}
__device__ __forceinline__ void xcd_barrier_complete(unsigned* bar, unsigned x, unsigned& nloc, unsigned& nx) {
    const unsigned G = gridDim.x * gridDim.y * gridDim.z;
    unsigned sum, cnt, mine, sp = 0u;
    for (;;) {
        sum = 0u; cnt = 0u; mine = 0u;
#pragma unroll
        for (unsigned j = 0; j < 16; ++j) { const unsigned c = xb_ld(&bar[XB_XCNT(j)]); sum += c; cnt += (c > 0u) ? 1u : 0u; mine = (j == x) ? c : mine; }
        if (sum == G) break;
        __builtin_amdgcn_s_sleep(1);
        if ((++sp & 255u) == 0u) { if (xb_ld(&bar[XB_TMO])) break; if (sp > XB_SPIN_CAP) { atomicAdd(&bar[XB_TMO], 1u); break; } }
    }
    nloc = mine > 0u ? mine : 1u; nx = cnt > 0u ? cnt : 1u;
}

__device__ __forceinline__ void xcd_barrier(const XcdBarrier& b) {
    asm volatile("s_waitcnt vmcnt(0)" ::: "memory");
    __syncthreads();
    if (threadIdx.x == 0) {
        unsigned* bar = b.bar;
        __builtin_amdgcn_s_waitcnt(0);
        unsigned nloc = b.st[0], nx = b.st[1];
        if (nloc == 0u) { xcd_barrier_complete(bar, b.x, nloc, nx); b.st[0] = nloc; b.st[1] = nx; }
        const unsigned old = xb_add(&bar[XB_XSUB(b.x)], 1u);
        const unsigned gen = old / nloc;
        if (old + 1u == (gen + 1u) * nloc) {
            __builtin_amdgcn_fence(__ATOMIC_RELEASE, "agent");
            asm volatile("s_waitcnt vmcnt(0)" ::: "memory");
            const unsigned og = xb_add(&bar[XB_TOP], 1u);
            const unsigned tg = og / nx;
            if (og + 1u == (tg + 1u) * nx) xb_add(&bar[XB_TOPGEN], 1u);
            else XB_SPIN(xb_ld(&bar[XB_TOPGEN]) == tg, bar);
            __builtin_amdgcn_fence(__ATOMIC_ACQUIRE, "agent");
            xb_add(&bar[XB_XGEN(b.x)], 1u);
            asm volatile("s_waitcnt vmcnt(0)" ::: "memory");
        } else {
            XB_SPIN(xb_ld(&bar[XB_XGEN(b.x)]) == gen, bar);
            __builtin_amdgcn_fence(__ATOMIC_ACQUIRE, "agent");
            asm volatile("s_waitcnt vmcnt(0)" ::: "memory");
        }
    }
    __syncthreads();
}

__device__ __forceinline__ void xcd_barrier_shadow(const XcdBarrier& b, const Args& A, LAS unsigned char* lds, int seam, int bx, int wave, int lane, bool on) {
    asm volatile("s_waitcnt vmcnt(0)" ::: "memory");
    __syncthreads();
    if (wave == 0) {
      if (threadIdx.x == 0) {
        unsigned* bar = b.bar;
        __builtin_amdgcn_s_waitcnt(0);
        unsigned nloc = b.st[0], nx = b.st[1];
        if (nloc == 0u) { xcd_barrier_complete(bar, b.x, nloc, nx); b.st[0] = nloc; b.st[1] = nx; }
        const unsigned old = xb_add(&bar[XB_XSUB(b.x)], 1u);
        const unsigned gen = old / nloc;
        if (old + 1u == (gen + 1u) * nloc) {
            __builtin_amdgcn_fence(__ATOMIC_RELEASE, "agent");
            asm volatile("s_waitcnt vmcnt(0)" ::: "memory");
            const unsigned og = xb_add(&bar[XB_TOP], 1u);
            const unsigned tg = og / nx;
            if (og + 1u == (tg + 1u) * nx) xb_add(&bar[XB_TOPGEN], 1u);
            else XB_SPIN(xb_ld(&bar[XB_TOPGEN]) == tg, bar);
            __builtin_amdgcn_fence(__ATOMIC_ACQUIRE, "agent");
            xb_add(&bar[XB_XGEN(b.x)], 1u);
            asm volatile("s_waitcnt vmcnt(0)" ::: "memory");
        } else {
            XB_SPIN(xb_ld(&bar[XB_XGEN(b.x)]) == gen, bar);
            __builtin_amdgcn_fence(__ATOMIC_ACQUIRE, "agent");
            asm volatile("s_waitcnt vmcnt(0)" ::: "memory");
        }
      }
    } else if (on) {
        const int j = (seam - 1) * SHADOW_PER_SEAM + bx * (NWAVES - 1) + (wave - 1);
        if (j < SHADOW_N) { const P0Item d = p0_decode(A, shadow_item_id(j)); f32x4 v[8]; p0_load(d, v, lane); p0_store(d, v, (LAS float*)(lds + wave * 16384), lane); }
    }
    __syncthreads();
}

#ifndef ATTN_V2
#define ATTN_V2 1
#endif
#if ATTN_V2
#define ATTN_CALL(b_, h_, qb_) attn_body::attn_unit<40>((b_), (h_), (qb_), (const attn_body::bf16*)QK, (const attn_body::bf16*)QK + 512, (const attn_body::bf16*)VA, (attn_body::bf16*)CAT + 512, (const attn_body::u32x4*)(ws + WS_FC8) + (size_t)((b_) * 8 + (h_)) * (SEQL / 2), js_, (char*)lds_raw)
#else
#define ATTN_CALL(b_, h_, qb_) do { (void)js_; att::attn_unit((b_), (h_), (qb_), QK, VA, CAT, FC, (char*)lds_raw); } while (0)
#endif
#ifndef MK_COOP
#define MK_COOP 1
#endif
__global__ void __launch_bounds__(NWAVES * 64, 2) trunk_fwd(Args args) {
    extern __shared__ __attribute__((aligned(16))) unsigned char lds_raw[];
    LAS unsigned char* lds = (LAS unsigned char*)lds_raw;
    cg::grid_group grid = cg::this_grid();
    const int tid = threadIdx.x, lane = tid & 63, wave = __builtin_amdgcn_readfirstlane(tid >> 6);
    const int G = gridDim.x; const int bx = blockIdx.x; const int vcu = (G % 8 == 0) ? (bx % 8) * (G / 8) + bx / 8 : bx;
    unsigned char* ws = args.ws;
    bf16* XB = (bf16*)(ws + WS_XB); bf16* HB = (bf16*)(ws + WS_H); float* ssp = (float*)(ws + WS_SSP);
    bf16* QK = (bf16*)(ws + WS_QK); bf16* VA = (bf16*)(ws + WS_VA); bf16* CAT = (bf16*)(ws + WS_CAT);
    const int lo = args.ph_lo, hi = args.ph_hi;
    volatile LAS unsigned* MISC = (volatile LAS unsigned*)(lds + MISC_OFF);
    if (tid < 32) MISC[tid] = 0u;
    __syncthreads();
    XcdBarrier bar = xcd_barrier_post((unsigned*)(ws + WS_CTL) + CW_BAR, MISC + 8);
#ifndef PH_MASK
#define PH_MASK 0xFFFF
#endif
#define IN(k) ((((PH_MASK) >> (k)) & 1) && lo <= (k) && (k) < hi)
#ifndef DUP_PHASE
#define DUP_PHASE -1
#endif
#ifndef DUP_MASK
#define DUP_MASK 0
#endif
#define REP(k) for (int rep_ = 0; rep_ < ((((DUP_MASK) >> (k)) & 1) ? 2 : 1); ++rep_)
#ifndef SYNC_EXTRA
#define SYNC_EXTRA 0
#endif
#define SEAM(k) do { if (IN(k) && IN((k) + 1)) { if ((k) == 0) grid.sync(); else xcd_barrier_shadow(bar, args, lds, (k), bx, wave, lane, deferred); for (int e_ = 0; e_ < ((k) == 1 ? SYNC_EXTRA : 0); ++e_) xcd_barrier(bar); } } while (0)
#define GEMM_GU(w) do { pg8::Gemm g{XB, (const bf16*)(ws + WS_WGU + (size_t)(w) * GU_BYTES), TOK, N_GU, DM}; pg8::StaticOrder S; S.init(TOK, N_GU, G, bx); \
        pg8::EpiSwiglu E{HB, ssp, DFF}; pg8::gemm_phase<pg8::EpiSwiglu, pg8::StaticOrder, true, true>(lds, g, S, E); } while (0)
#define GEMM_DN(w, FIN) do { pg8::Gemm g{HB, (const bf16*)(ws + WS_WDN + (size_t)(w) * DN_BYTES), TOK, DM, DFF}; pg8::StaticOrder S; S.init(TOK, DM, G, bx); \
        pg8::EpiResid<FIN> E{args.out, XB, ssp, 0.5f}; pg8::gemm_phase<pg8::EpiResid<FIN>, pg8::StaticOrder, true, true>(lds, g, S, E); } while (0)
#define GEMM_OUT(ASRC, WOFF) do { pg8::Gemm g{ASRC, (const bf16*)(ws + (WOFF)), TOK, DM, DM}; pg8::StaticOrder S; S.init(TOK, DM, G, bx); \
        pg8::EpiResid<false> E{args.out, XB, ssp, 1.0f}; pg8::gemm_phase<pg8::EpiResid<false>, pg8::StaticOrder, true, true>(lds, g, S, E); } while (0)

    const bool deferred = (G == 256) && lo == 0 && hi == N_PHASES;
    if (IN(0)) REP(0) { p0_prologue(args, lds, vcu * NWAVES + wave, G * NWAVES, wave, lane, deferred); } SEAM(0);
    if (IN(1)) { GEMM_GU(0); if ((DUP_PHASE) == 1) GEMM_GU(0); } SEAM(1);
    if (IN(2)) { GEMM_DN(0, false); } SEAM(2);
    if (IN(3)) REP(3) { pg8::Gemm g{XB, (const bf16*)(ws + WS_WEVIN), TOK, N_EVIN, DM}; pg8::StaticOrder S; S.init(TOK, N_EVIN, G, bx);
        pg8::EpiEvenIn E{QK, VA, (float*)(ws + WS_LF), ssp, args.in[15], args.in[16], args.in[11]}; pg8::gemm_phase<pg8::EpiEvenIn, pg8::StaticOrder, true, true>(lds, g, S, E);
        forget_mfma(args, lds, vcu, G, tid, wave, lane); } SEAM(3);
    if (IN(4)) REP(4) { prep_even(args, lds, vcu, G, tid, wave, lane); } SEAM(4);
    if (IN(5)) REP(5) { const float* FC = (const float*)(ws + WS_FC);
        float qkb; { float a = fabsf(args.in[15][lane]), b = fabsf(args.in[16][lane]);
#pragma unroll
            for (int o = 1; o < 64; o <<= 1) { a = fmaxf(a, __shfl_xor(a, o)); b = fmaxf(b, __shfl_xor(b, o)); }
            qkb = __uint_as_float(__builtin_amdgcn_readfirstlane(__float_as_uint(64.0f * 0.125f * pg8::LOG2E * a * b * 1.01f))); }
        unsigned* qctr = (unsigned*)(ws + WS_CTL) + CW_QUEUE; const int nq = (G >= 8) ? 8 : 1; const int myq = bx % nq;
        for (int qi = 0; qi < nq; ++qi) { const int q = (myq + qi) % nq;
          for (;;) {
            if (tid == 0) MISC[16] = atomicAdd(qctr + 64 * q, 1u);
            __syncthreads(); const int un = (int)MISC[16]; __syncthreads();
            if (un >= 1024 / nq) break;
            int bh, qb; if (nq == 8) { qb = 15 - (un >> 3); bh = q * 8 + (un & 7); } else { qb = 15 - (un >> 6); bh = un & 63; }
            int js_ = 0;
#if ATTN_V2
            { const float* fcr = FC + (size_t)bh * SEQL; const int ntile = 4 * qb + 4; const float ref = fcr[256 * qb]; int ln_ = threadIdx.x & 63; asm volatile("" : "+v"(ln_));
              const bool c = (ln_ < ntile - 4) && (ref - fcr[64 * ln_ + 63] > 2.0f * qkb + 40.0f);
              js_ = (int)__builtin_popcountll(__ballot(c)) & ~1; js_ = __builtin_amdgcn_readfirstlane(js_); }
#endif
            ATTN_CALL(bh >> 3, bh & 7, qb); } } } SEAM(5);
    if (IN(6)) GEMM_OUT(CAT, WS_WEVOUT); SEAM(6);
    if (IN(7)) GEMM_GU(1); SEAM(7);
    if (IN(8)) GEMM_DN(1, false); SEAM(8);
    if (IN(9)) GEMM_GU(2); SEAM(9);
    if (IN(10)) GEMM_DN(2, false); SEAM(10);
    if (IN(11)) REP(11) { pg8::Gemm g{XB, (const bf16*)(ws + WS_WODIN), TOK, N_ODIN, DM}; pg8::StaticOrder S; S.init(TOK, N_ODIN, G, bx);
        pg8::EpiOddIn E{VA  , QK  , ssp}; pg8::gemm_phase<pg8::EpiOddIn, pg8::StaticOrder, true, true>(lds, g, S, E); } SEAM(11);
    if (IN(12)) REP(12) { conv_odd(args, vcu, G, tid); } SEAM(12);
    if (IN(13)) GEMM_OUT(CAT  , WS_WODOUT); SEAM(13);
    if (IN(14)) GEMM_GU(3); SEAM(14);
    if (IN(15)) GEMM_DN(3, true);
#undef IN
#undef SEAM
}

extern "C" void kernel_launch(void* const* d_in, const int* in_sizes, int n_in, void* d_out, int out_size, void* d_ws, size_t ws_size, hipStream_t stream) {
    static int grid = 0;
    if (grid == 0) {
        if (n_in != 21 || in_sizes[0] != TOK * DM || out_size != TOK * DM || ws_size < WS_END) { fprintf(stderr, "kernel_launch: unexpected shapes (n_in %d, in0 %d, out %d, ws %zu); nothing launched\n", n_in, n_in > 0 ? in_sizes[0] : -1, out_size, ws_size); grid = -1; return; }
        int dev = 0, cus = 0, per_cu = 0;
        if (hipGetDevice(&dev) != hipSuccess || hipDeviceGetAttribute(&cus, hipDeviceAttributeMultiprocessorCount, dev) != hipSuccess) { grid = -1; return; }
        if (hipFuncSetAttribute((const void*)trunk_fwd, hipFuncAttributeMaxDynamicSharedMemorySize, LDS_BYTES) != hipSuccess) { fprintf(stderr, "kernel_launch: hipFuncSetAttribute failed\n"); grid = -1; return; }
        if (hipOccupancyMaxActiveBlocksPerMultiprocessor(&per_cu, (const void*)trunk_fwd, NWAVES * 64, LDS_BYTES) != hipSuccess || per_cu < 1) { fprintf(stderr, "kernel_launch: occupancy query says %d\n", per_cu); per_cu = 1; }
        (void)hipGetLastError();
        grid = cus * 1;
    }
    if (grid < 0) return;
    if (hipMemsetAsync((char*)d_ws + WS_CTL, 0, CTL_ZERO_BYTES, stream) != hipSuccess) { fprintf(stderr, "kernel_launch: memset failed\n"); return; }
    Args a{};
    for (int i = 0; i < 21; ++i) a.in[i] = (const float*)d_in[i];
    a.out = (float*)d_out; a.ws = (unsigned char*)d_ws;
#if MK_COOP
    a.ph_lo = 0; a.ph_hi = N_PHASES;
    void* kargs[] = {&a};
    hipError_t e = hipLaunchCooperativeKernel((const void*)trunk_fwd, dim3(grid), dim3(NWAVES * 64), kargs, LDS_BYTES, stream);
    if (e != hipSuccess) fprintf(stderr, "kernel_launch: cooperative launch failed: %s (grid %d)\n", hipGetErrorString(e), grid);
#else
    for (int p = 0; p < N_PHASES; ++p) { a.ph_lo = p; a.ph_hi = p + 1; hipLaunchKernelGGL(trunk_fwd, dim3(grid), dim3(NWAVES * 64), LDS_BYTES, stream, a); }
#endif
}
```
